# Optimizing an MI355X kernel written in HIP

```python
import jax, jax.numpy as jnp
from jax import lax
import numpy as np

D_MODEL = 1024
BATCH = 4
SEQ = 8192
DEPTH = 4

N_A_LAYERS = DEPTH // 2
N_B_LAYERS = DEPTH - N_A_LAYERS
D_FF = 2816
CONV_WIDTH = 3
HEAD_DIM = 64
HEADS_PER_GROUP = 8
DILATED_GROUPS = ((128, 1), (512, 4), (2048, 16))
N_GROUPS = len(DILATED_GROUPS)
N_Q_HEADS = N_GROUPS * HEADS_PER_GROUP
Q_WIDTH = N_Q_HEADS * HEAD_DIM
OUT_WIDTH = HEADS_PER_GROUP * HEAD_DIM
ROPE_DIM = HEAD_DIM // 4
ROPE_THETA = 500000.0
NORM_EPS = 1e-5
FFN_RES_WEIGHT = 0.5
N_MOD = 9

kernel_name = "hybrid_shortconv_dilated_yoco_trunk"


def rms_norm(x, g):
    xf = x.astype(jnp.float32)
    y = xf * lax.rsqrt(jnp.mean(xf * xf, axis=-1, keepdims=True) + NORM_EPS)
    return (y * g.astype(jnp.float32)).astype(x.dtype)


def modulate(h, shift, scale):
    return h * (1 + scale[:, None, :]) + shift[:, None, :]


def swiglu(h, w_in, w_out):
    a, b = jnp.split(h @ w_in, 2, axis=-1)
    return (jax.nn.silu(a) * b) @ w_out


def short_conv_mixer(h, w_in, conv_w, w_out):
    b_gate, c_gate, u = jnp.split(h @ w_in, 3, axis=-1)
    v = c_gate * u
    conv = lax.conv_general_dilated(
        v, conv_w[:, None, :], window_strides=(1,), padding=[(CONV_WIDTH - 1, 0)],
        dimension_numbers=('NWC', 'WIO', 'NWC'), feature_group_count=D_MODEL)
    return (b_gate * conv) @ w_out


def rope_tables(positions):
    inv = ROPE_THETA ** (-jnp.arange(0, ROPE_DIM, 2, dtype=jnp.float32) / ROPE_DIM)
    ang = positions.astype(jnp.float32)[..., None] * inv
    return jnp.cos(ang)[:, :, None, :], jnp.sin(ang)[:, :, None, :]


def apply_partial_rope(t, cos, sin):
    tf = t.astype(jnp.float32)
    r1 = tf[..., :ROPE_DIM // 2]
    r2 = tf[..., ROPE_DIM // 2:ROPE_DIM]
    out = jnp.concatenate([r1 * cos - r2 * sin, r2 * cos + r1 * sin, tf[..., ROPE_DIM:]], axis=-1)
    return out.astype(t.dtype)


def dilated_window_attention(q, k, v, window, dilation):
    bsz, seq, nh, hd = q.shape
    n = window // dilation
    span = n * dilation
    seq_p = -(-seq // span) * span
    pad = seq_p - seq
    m_len = seq_p // dilation
    nb = m_len // n

    def to_blocks(t):
        t = jnp.pad(t, ((0, 0), (0, pad), (0, 0), (0, 0)))
        t = t.reshape(bsz, m_len, dilation, nh, hd).transpose(0, 2, 3, 1, 4)
        return t.reshape(bsz, dilation, nh, nb, n, hd)

    def with_prev(t):
        prev = jnp.pad(t[:, :, :, :-1], ((0, 0), (0, 0), (0, 0), (1, 0), (0, 0), (0, 0)))
        return jnp.concatenate([prev, t], axis=-2)

    qb = to_blocks(q)
    kk = with_prev(to_blocks(k))
    vv = with_prev(to_blocks(v))
    s = jnp.einsum('brhiqe,brhike->brhiqk', qb, kk,
                   preferred_element_type=jnp.float32) * (hd ** -0.5)
    blk = jnp.arange(nb)[:, None, None]
    qi = jnp.arange(n)[None, :, None]
    kj = jnp.arange(2 * n)[None, None, :]
    dist = n + qi - kj
    valid = (dist >= 0) & (dist <= n) & ((blk - 1) * n + kj >= 0)
    s = jnp.where(valid, s, -jnp.inf)
    m = jnp.max(s, axis=-1, keepdims=True)
    p = jnp.exp(s - m)
    den = jnp.sum(p, axis=-1, keepdims=True)
    o = jnp.einsum('brhiqk,brhike->brhiqe', (p / den).astype(v.dtype), vv)
    lse = (m + jnp.log(den))[..., 0]
    o = o.reshape(bsz, dilation, nh, m_len, hd).transpose(0, 3, 1, 2, 4).reshape(bsz, seq_p, nh, hd)
    lse = lse.reshape(bsz, dilation, nh, m_len).transpose(0, 3, 1, 2).reshape(bsz, seq_p, nh)
    return o[:, :seq], lse[:, :seq]


def dilated_attention_mixer(h, w_q, w_o, k_sh, v_sh, cos, sin):
    bsz, seq, _ = h.shape
    q = apply_partial_rope((h @ w_q).reshape(bsz, seq, N_Q_HEADS, HEAD_DIM), cos, sin)
    outs, lses = [], []
    for g, (win, dil) in enumerate(DILATED_GROUPS):
        sl = slice(g * HEADS_PER_GROUP, (g + 1) * HEADS_PER_GROUP)
        o, l = dilated_window_attention(q[:, :, sl], k_sh[:, :, sl], v_sh[:, :, sl], win, dil)
        outs.append(o)
        lses.append(l)
    o = jnp.stack(outs, axis=0).astype(jnp.float32)
    w = jax.nn.softmax(jnp.stack(lses, axis=0), axis=0)
    mixed = jnp.sum(w[..., None] * o, axis=0).astype(h.dtype)
    return mixed.reshape(bsz, seq, OUT_WIDTH) @ w_o


def shared_kv(x, g, shift, scale, w_kv, cos, sin):
    bsz, seq, _ = x.shape
    h = modulate(rms_norm(x, g), shift, scale)
    k, v = jnp.split(h @ w_kv, 2, axis=-1)
    k = apply_partial_rope(k.reshape(bsz, seq, N_Q_HEADS, HEAD_DIM), cos, sin)
    v = v.reshape(bsz, seq, N_Q_HEADS, HEAD_DIM)
    return k, v


def setup_inputs(seed: int = 0) -> dict:
    key = jax.random.key(seed)
    ks = jax.random.split(key, 24)
    f32 = jnp.float32
    D, F = D_MODEL, D_FF

    def nrm(k, shape, fan_in, mult=1.0):
        return jax.random.normal(k, shape, f32) * (mult * fan_in ** -0.5)

    x = jax.random.normal(ks[0], (BATCH, SEQ, D), f32)
    c = jax.random.normal(ks[1], (BATCH, D), f32)
    offset = jax.random.randint(ks[2], (BATCH, 1), 0, 1024, dtype=jnp.int32)
    positions = offset + jnp.arange(SEQ, dtype=jnp.int32)[None, :]
    return {
        "x": x,
        "c": c,
        "positions": positions,
        "norm_g": 1.0 + 0.02 * jax.random.normal(ks[3], (DEPTH, 3, D), f32),
        "ada_w": nrm(ks[4], (DEPTH, D, N_MOD * D), D, 0.1),
        "ada_b": 0.01 * jax.random.normal(ks[5], (DEPTH, N_MOD * D), f32),
        "ffn1_w_in": nrm(ks[6], (DEPTH, D, 2 * F), D),
        "ffn1_w_out": nrm(ks[7], (DEPTH, F, D), F),
        "ffn2_w_in": nrm(ks[8], (DEPTH, D, 2 * F), D),
        "ffn2_w_out": nrm(ks[9], (DEPTH, F, D), F),
        "conv_w_in": nrm(ks[10], (N_A_LAYERS, D, 3 * D), D),
        "conv_w": nrm(ks[11], (N_A_LAYERS, CONV_WIDTH, D), CONV_WIDTH),
        "conv_w_out": nrm(ks[12], (N_A_LAYERS, D, D), D),
        "kv_norm_g": 1.0 + 0.02 * jax.random.normal(ks[13], (D,), f32),
        "kv_ada_w": nrm(ks[14], (D, 2 * D), D, 0.1),
        "kv_ada_b": 0.01 * jax.random.normal(ks[15], (2 * D,), f32),
        "w_kv": nrm(ks[16], (D, 2 * Q_WIDTH), D),
        "attn_w_q": nrm(ks[17], (N_B_LAYERS, D, Q_WIDTH), D),
        "attn_w_o": nrm(ks[18], (N_B_LAYERS, OUT_WIDTH, D), OUT_WIDTH),
        "final_norm_g": 1.0 + 0.02 * jax.random.normal(ks[19], (D,), f32),
    }


def reference(x, c, positions, norm_g, ada_w, ada_b, ffn1_w_in, ffn1_w_out, ffn2_w_in, ffn2_w_out,
              conv_w_in, conv_w, conv_w_out, kv_norm_g, kv_ada_w, kv_ada_b, w_kv,
              attn_w_q, attn_w_o, final_norm_g):
    cond = jax.nn.silu(c)
    cos, sin = rope_tables(positions)
    k_sh = v_sh = None
    for layer in range(DEPTH):
        if layer == N_A_LAYERS:
            kv_shift, kv_scale = jnp.split(cond @ kv_ada_w + kv_ada_b, 2, axis=-1)
            k_sh, v_sh = shared_kv(x, kv_norm_g, kv_shift, kv_scale, w_kv, cos, sin)
        mods = cond @ ada_w[layer] + ada_b[layer]
        sh1, sc1, g1, sh2, sc2, g2, sh3, sc3, g3 = jnp.split(mods, N_MOD, axis=-1)
        h = modulate(rms_norm(x, norm_g[layer, 0]), sh1, sc1)
        x = x + FFN_RES_WEIGHT * (1 + g1)[:, None, :] * swiglu(h, ffn1_w_in[layer], ffn1_w_out[layer])
        h = modulate(rms_norm(x, norm_g[layer, 1]), sh2, sc2)
        if layer < N_A_LAYERS:
            mix = short_conv_mixer(h, conv_w_in[layer], conv_w[layer], conv_w_out[layer])
        else:
            j = layer - N_A_LAYERS
            mix = dilated_attention_mixer(h, attn_w_q[j], attn_w_o[j], k_sh, v_sh, cos, sin)
        x = x + (1 + g2)[:, None, :] * mix
        h = modulate(rms_norm(x, norm_g[layer, 2]), sh3, sc3)
        x = x + FFN_RES_WEIGHT * (1 + g3)[:, None, :] * swiglu(h, ffn2_w_in[layer], ffn2_w_out[layer])
    return rms_norm(x, final_norm_g)
```

```cpp
#include <hip/hip_runtime.h>
#include <hip/hip_cooperative_groups.h>
#include <cstdio>
#include <cstdint>
#include <cmath>
namespace cg = cooperative_groups;
namespace pg8 {
#define PG8_LAS __attribute__((address_space(3)))
typedef unsigned short bf16_t;
typedef short bf16x8 __attribute__((ext_vector_type(8)));
typedef float f32x4 __attribute__((ext_vector_type(4)));
typedef unsigned u32x4 __attribute__((ext_vector_type(4)));
constexpr int BM = 256, BK = 64, HALF = 128, HTB = HALF * BK * 2  , STAGE_BYTES = 8 * HTB, NXCD = 8, WGM = 8;

__host__ __device__ __forceinline__ int lds_byte(int r, int c) { const int st = (r >> 4) * 2 + (c >> 5), rr = r & 15, cc = c & 31, ob = rr * 64 + cc * 2; return st * 1024 + (ob ^ (((ob >> 9) & 1) << 5)); }
__host__ __device__ __forceinline__ void stage_rc(int b, int& R, int& C) { const int st = b / 1024, sb = b % 1024, swz = sb ^ (((sb >> 9) & 1) << 5); R = (st >> 1) * 16 + swz / 64; C = (st & 1) * 32 + (swz % 64) / 2; }
__host__ __device__ __forceinline__ int perm32(int rho) { const int n = rho >> 4, i = rho & 15; return 8 * (i >> 2) + 4 * n + (i & 3); }

struct Unit { int pm, pn; };
struct Gemm { const bf16_t* A; const bf16_t* Bt; int M, N, K; int ablk; };

struct StaticOrder {
    int nM, nN, nwg, G, c;
    __host__ __device__ void init(int M, int N, int G_, int c_) { nM = M / BM; nN = N / BM; nwg = nM * nN; G = G_; c = c_; }
    __host__ __device__ bool next(int i, Unit& u) const {
        const long L = (long)i * G + c; if (L >= nwg) return false;
        int wgid = (int)L; { const int q = nwg / NXCD, r = nwg % NXCD, xcd = wgid % NXCD, off = wgid / NXCD; wgid = (xcd < r ? xcd * (q + 1) : r * (q + 1) + (xcd - r) * q) + off; }
        const int nig = WGM * nN, gid = wgid / nig, fm = gid * WGM, gsz = (nM - fm) < WGM ? (nM - fm) : WGM;
        u.pm = fm + ((wgid % nig) % gsz); u.pn = (wgid % nig) / gsz; return true;
    }
    __device__ __forceinline__ void a_ready(const Unit&) const {}
    __device__ __forceinline__ void done(const Unit&) const {}
};
__device__ __forceinline__ unsigned cvt_pk_bf16(float lo, float hi) { unsigned r; asm volatile("v_cvt_pk_bf16_f32 %0, %1, %2" : "=v"(r) : "v"(lo), "v"(hi)); return r; }
template <class Epi, class Sched, bool ALIGN_EPI = false, bool SP2 = false>
__device__ __forceinline__ void gemm_phase(PG8_LAS unsigned char* lds, const Gemm g, const Sched& S, const Epi& E, const int tid) {
    const int wid = __builtin_amdgcn_readfirstlane(tid >> 6), lane = tid & 63, wr = wid >> 2, wc = wid & 3, fr = lane & 15, fq = lane >> 4;
    const int K = g.K, nt = K / BK;
    unsigned voffA[2], voffB[2];
#pragma unroll
    for (int i = 0; i < 2; ++i) { int R, C; stage_rc(tid * 16 + i * 8192, R, C); const int Rb = Epi::PERM ? ((R & ~31) + perm32(R & 31)) : R;
        voffA[i] = g.ablk ? (unsigned)(R * 64 + C) * 2u : (unsigned)(R * K + C) * 2u; voffB[i] = (unsigned)(Rb * K + C) * 2u; }
    const size_t kstep = (size_t)(BK * 2);
    const size_t hstep = (size_t)HALF * K * 2;
    const size_t tstep = 2 * hstep;
    const size_t kstepA = g.ablk ? (size_t)32768 : kstep, hstepA = g.ablk ? (size_t)16384 : hstep;
    const unsigned ldsw = (unsigned)wid * 1024u;
    const int aoff = lds_byte(wr * 64 + fr, fq * 8), boff = lds_byte(wc * 32 + fr, fq * 8);
#define PG8_SA(b, h) (((b) * 2 + (h)) * HTB)
#define PG8_SB(b, h) ((4 + (b) * 2 + (h)) * HTB)
#define PG8_STAGE(bufoff, gbase, voff) do { _Pragma("unroll") for (int _i = 0; _i < 2; ++_i) \
        __builtin_amdgcn_global_load_lds((const unsigned*)((const char*)(gbase) + (voff)[_i]), (PG8_LAS unsigned*)(lds + (bufoff) + ldsw + _i * 8192), 16, 0, 0); } while (0)
#define PG8_LDA(dst, b, h) do { _Pragma("unroll") for (int m = 0; m < 4; ++m) _Pragma("unroll") for (int k = 0; k < 2; ++k) dst[m][k] = *(const PG8_LAS bf16x8*)(lds + PG8_SA(b, h) + aoff + m * 2048 + k * 1024); } while (0)
#define PG8_LDB(dst, b, h) do { _Pragma("unroll") for (int n = 0; n < 2; ++n) _Pragma("unroll") for (int k = 0; k < 2; ++k) dst[n][k] = *(const PG8_LAS bf16x8*)(lds + PG8_SB(b, h) + boff + n * 2048 + k * 1024); } while (0)
#define PG8_MMA(ai, bj, At, Bt) do { __builtin_amdgcn_s_setprio(1); _Pragma("unroll") for (int m = 0; m < 4; ++m) _Pragma("unroll") for (int n = 0; n < 2; ++n) _Pragma("unroll") for (int k = 0; k < 2; ++k) \
        acc[ai][bj][m][n] = __builtin_amdgcn_mfma_f32_16x16x32_bf16(Bt[n][k], At[m][k], acc[ai][bj][m][n], 0, 0, 0); __builtin_amdgcn_s_setprio(0); } while (0)
#define PG8_WAIT_V(n) asm volatile("s_waitcnt vmcnt(" #n ")" ::: "memory")
#define PG8_WAIT_L(n) asm volatile("s_waitcnt lgkmcnt(" #n ")" ::: "memory")
#define PG8_BAR __builtin_amdgcn_s_barrier()
#define PG8_SCHED __builtin_amdgcn_sched_barrier(0)
    Unit cur, nxt; int ui = 0;
    if (!S.next(0, cur)) return;
    f32x4 acc[2][2][4][2];
#pragma unroll
    for (int a = 0; a < 2; ++a)
#pragma unroll
        for (int b = 0; b < 2; ++b)
#pragma unroll
            for (int m = 0; m < 4; ++m)
#pragma unroll
                for (int n = 0; n < 2; ++n) acc[a][b][m][n] = (f32x4){0.f, 0.f, 0.f, 0.f};
    bf16x8 At[4][2], B0[2][2], B1[2][2];
    const char* cA = (const char*)g.A + (size_t)cur.pm * tstep; const char* cB = (const char*)g.Bt + (size_t)cur.pn * tstep;
    S.a_ready(cur);
    if constexpr (SP2) {
        PG8_STAGE(PG8_SB(0, 0), cB, voffB); PG8_STAGE(PG8_SB(0, 1), cB + hstep, voffB); PG8_STAGE(PG8_SA(0, 0), cA, voffA); PG8_STAGE(PG8_SA(0, 1), cA + hstepA, voffA);
        if (wr == 1) PG8_BAR;
        PG8_WAIT_V(2); PG8_BAR;
        PG8_STAGE(PG8_SB(1, 0), cB + kstep, voffB); PG8_STAGE(PG8_SA(1, 0), cA + kstepA, voffA); PG8_STAGE(PG8_SB(1, 1), cB + hstep + kstep, voffB);
        PG8_WAIT_V(6); PG8_BAR;
    } else {
        PG8_STAGE(PG8_SB(0, 0), cB, voffB); PG8_STAGE(PG8_SA(0, 0), cA, voffA); PG8_STAGE(PG8_SB(0, 1), cB + hstep, voffB); PG8_STAGE(PG8_SA(0, 1), cA + hstepA, voffA);
        if (wr == 1) PG8_BAR;
        PG8_WAIT_V(4); PG8_BAR;
        PG8_STAGE(PG8_SB(1, 0), cB + kstep, voffB); PG8_STAGE(PG8_SA(1, 0), cA + kstepA, voffA); PG8_STAGE(PG8_SB(1, 1), cB + hstep + kstep, voffB);
        PG8_WAIT_V(6); PG8_BAR;
    }
    for (;;) {
        const bool has_next = S.next(ui + 1, nxt);
        const char* nA = has_next ? (const char*)g.A + (size_t)nxt.pm * tstep : cA; const char* nB = has_next ? (const char*)g.Bt + (size_t)nxt.pn * tstep : cB;
        for (int t = 0; t < nt; t += 2) {
            const bool last = (t == nt - 2);
            const char* a1 = cA + (size_t)(t + 1) * kstepA;
            const char* a2 = last ? nA : cA + (size_t)(t + 2) * kstepA; const char* b2 = last ? nB : cB + (size_t)(t + 2) * kstep;
            const char* a3 = a2 + kstepA; const char* b3 = b2 + kstep;
            if (last && has_next) S.a_ready(nxt);
            if constexpr (SP2) {
            PG8_LDB(B0, 0, 0); PG8_LDB(B1, 0, 1); PG8_SCHED; PG8_LDA(At, 0, 0); PG8_STAGE(PG8_SA(1, 1), a1 + hstepA, voffA);
            PG8_WAIT_V(8); PG8_WAIT_L(0); PG8_BAR; PG8_MMA(0, 0, At, B0); PG8_MMA(0, 1, At, B1); PG8_BAR; PG8_SCHED;
            PG8_LDA(At, 0, 1); PG8_STAGE(PG8_SB(0, 0), b2, voffB); PG8_STAGE(PG8_SB(0, 1), b2 + hstep, voffB); PG8_STAGE(PG8_SA(0, 0), a2, voffA);
            PG8_WAIT_V(8); PG8_WAIT_L(0); PG8_BAR; PG8_MMA(1, 0, At, B0); PG8_MMA(1, 1, At, B1); PG8_BAR; PG8_SCHED;
            PG8_LDB(B0, 1, 0); PG8_LDB(B1, 1, 1); PG8_SCHED; PG8_LDA(At, 1, 0); PG8_STAGE(PG8_SA(0, 1), a2 + hstepA, voffA);
            PG8_WAIT_V(8); PG8_WAIT_L(0); PG8_BAR; PG8_MMA(0, 0, At, B0); PG8_MMA(0, 1, At, B1); PG8_BAR; PG8_SCHED;
            PG8_LDA(At, 1, 1); PG8_STAGE(PG8_SB(1, 0), b3, voffB); PG8_STAGE(PG8_SB(1, 1), b3 + hstep, voffB); PG8_STAGE(PG8_SA(1, 0), a3, voffA);
            PG8_WAIT_V(8); PG8_WAIT_L(0); PG8_BAR; PG8_MMA(1, 0, At, B0); PG8_MMA(1, 1, At, B1); PG8_BAR; PG8_SCHED;
            } else {
            PG8_LDB(B0, 0, 0); PG8_SCHED; PG8_LDA(At, 0, 0); PG8_STAGE(PG8_SA(1, 1), a1 + hstepA, voffA);
            PG8_WAIT_L(8); PG8_BAR; PG8_WAIT_L(0); PG8_MMA(0, 0, At, B0); PG8_BAR; PG8_SCHED;
            PG8_LDB(B1, 0, 1); PG8_STAGE(PG8_SB(0, 0), b2, voffB);
            PG8_BAR; PG8_WAIT_L(0); PG8_MMA(0, 1, At, B1); PG8_BAR;
            PG8_LDA(At, 0, 1); PG8_STAGE(PG8_SA(0, 0), a2, voffA);
            PG8_BAR; PG8_WAIT_L(0); PG8_MMA(1, 0, At, B0); PG8_BAR; PG8_SCHED;
            PG8_STAGE(PG8_SB(0, 1), b2 + hstep, voffB);
            PG8_WAIT_V(6); PG8_BAR; PG8_MMA(1, 1, At, B1); PG8_BAR;
            PG8_LDB(B0, 1, 0); PG8_SCHED; PG8_LDA(At, 1, 0); PG8_STAGE(PG8_SA(0, 1), a2 + hstepA, voffA);
            PG8_WAIT_L(8); PG8_BAR; PG8_WAIT_L(0); PG8_MMA(0, 0, At, B0); PG8_BAR; PG8_SCHED;
            PG8_LDB(B1, 1, 1); PG8_STAGE(PG8_SB(1, 0), b3, voffB);
            PG8_BAR; PG8_WAIT_L(0); PG8_MMA(0, 1, At, B1); PG8_BAR;
            PG8_LDA(At, 1, 1); PG8_STAGE(PG8_SA(1, 0), a3, voffA);
            PG8_BAR; PG8_WAIT_L(0); PG8_MMA(1, 0, At, B0); PG8_BAR; PG8_SCHED;
            PG8_STAGE(PG8_SB(1, 1), b3 + hstep, voffB);
            PG8_WAIT_V(6); PG8_BAR; PG8_MMA(1, 1, At, B1); PG8_BAR;
            }
        }
        if constexpr (ALIGN_EPI) { if (wr == 0) PG8_BAR; }
        if constexpr (!Epi::AFTER_DRAIN) { E(acc, cur, wr, wc, fr, fq); S.done(cur); }
        if (!has_next) break;
#pragma unroll
        for (int a = 0; a < 2; ++a)
#pragma unroll
            for (int b = 0; b < 2; ++b)
#pragma unroll
                for (int m = 0; m < 4; ++m)
#pragma unroll
                    for (int n = 0; n < 2; ++n) acc[a][b][m][n] = (f32x4){0.f, 0.f, 0.f, 0.f};
        cur = nxt; cA = nA; cB = nB; ++ui;
        if constexpr (ALIGN_EPI) { if (wr == 1) PG8_BAR; }
    }
    PG8_WAIT_V(0);
    if constexpr (!ALIGN_EPI) { if (wr == 0) PG8_BAR; }
    PG8_BAR;
    if constexpr (Epi::AFTER_DRAIN) { E.fused(acc, cur, wr, wc, fr, fq, lds, wid, lane); S.done(cur); }
#undef PG8_SA
#undef PG8_SB
#undef PG8_STAGE
#undef PG8_LDA
#undef PG8_LDB
#undef PG8_MMA
#undef PG8_WAIT_V
#undef PG8_WAIT_L
#undef PG8_BAR
#undef PG8_SCHED
}
}

#ifndef MK_PER_PHASE
#define MK_PER_PHASE 0
#endif

#define LAS __attribute__((address_space(3)))
typedef unsigned short bf16;
typedef unsigned v4u __attribute__((ext_vector_type(4)));
typedef unsigned v2u __attribute__((ext_vector_type(2)));
typedef float f32x4 __attribute__((ext_vector_type(4)));
typedef short bf16x8 __attribute__((ext_vector_type(8)));
using pg8::cvt_pk_bf16;

constexpr int NB = 4, SEQ = 8192, D = 1024, T = NB * SEQ, FF = 2816, NFF2 = 2 * FF, QW = 1536, OW = 512;
constexpr float EPS = 1e-5f;
constexpr int NMODCOL = 4 * 9216 + 2048;

constexpr size_t MiB = 1u << 20;
constexpr size_t WS_SUMSQ = 557 * MiB;
constexpr size_t WS_CS    = 2 * MiB;
constexpr size_t WS_MODP  = 4 * MiB;
constexpr size_t WS_TAB   = 9 * MiB;
constexpr size_t WS_SW    = 10 * MiB;
constexpr size_t WS_W     = 11 * MiB;
constexpr size_t W_F1IN = WS_W, W_F1OUT = W_F1IN + 11 * MiB, W_F2IN = W_F1OUT + 6 * MiB, W_F2OUT = W_F2IN + 11 * MiB, W_MXIN = W_F2OUT + 6 * MiB, W_MXOUT = W_MXIN + 6 * MiB, W_KV = W_MXOUT + 2 * MiB;
constexpr size_t WS_XS    = 60 * MiB;
constexpr size_t WS_H     = 124 * MiB;
constexpr size_t WS_V1 = WS_H, WS_BG = WS_H + 64 * MiB;
constexpr size_t WS_Q = WS_H, WS_OG2 = WS_H + 96 * MiB, WS_MIX = WS_H + 128 * MiB, WS_LSE = WS_H + 160 * MiB;
constexpr size_t WS_K     = 300 * MiB;
constexpr size_t WS_V     = 396 * MiB;
constexpr size_t WS_X16   = 492 * MiB;
constexpr size_t WS_CTL   = 556 * MiB;
constexpr size_t CTL_BYTES = 65536;
constexpr size_t WS_END   = 561 * MiB;
static_assert(W_KV + 6 * MiB <= WS_XS, "weights");
constexpr int SW_F1 = 0, SW_MX = 4 * NFF2, SW_F2 = SW_MX + 4 * 3072, SW_KV = SW_F2 + 4 * NFF2, SW_SZ = SW_KV + 4 * 3072;
constexpr size_t WB1_OFF = 64 * MiB;

constexpr int LDS_BYTES = 147456;

enum { PH_P0A = 0, PH_P0B, PH_P0C, PH_PW, PH_SWP, PH_PAIR, PH_RES, PH_ROPE, PH_CONVEW, PH_ATTN, PH_MERGE, PH_FINAL };
#define OP(t, L, sb) (unsigned char)((t) | ((L) << 4) | ((sb) << 6))
__constant__ unsigned char SCHED[] = {
    OP(PH_P0A, 0, 0), OP(PH_P0B, 0, 0), OP(PH_P0C, 0, 0),
    OP(PH_PAIR, 0, 0), OP(PH_RES, 0, 0), OP(PH_PAIR, 0, 1), OP(PH_CONVEW, 0, 0), OP(PH_RES, 0, 1), OP(PH_PAIR, 0, 2), OP(PH_RES, 0, 2),
    OP(PH_PAIR, 1, 0), OP(PH_RES, 1, 0), OP(PH_PAIR, 1, 1), OP(PH_CONVEW, 1, 0), OP(PH_RES, 1, 1), OP(PH_PAIR, 1, 2), OP(PH_RES, 1, 2),
    OP(PH_ROPE, 2, 1),
    OP(PH_PAIR, 2, 0), OP(PH_RES, 2, 0), OP(PH_ROPE, 2, 0), OP(PH_ATTN, 2, 0), OP(PH_MERGE, 2, 0), OP(PH_RES, 2, 1), OP(PH_PAIR, 2, 2), OP(PH_RES, 2, 2),
    OP(PH_PAIR, 3, 0), OP(PH_RES, 3, 0), OP(PH_ROPE, 3, 0), OP(PH_ATTN, 3, 0), OP(PH_MERGE, 3, 0), OP(PH_RES, 3, 1), OP(PH_PAIR, 3, 2), OP(PH_RES, 3, 2),
    OP(PH_FINAL, 0, 0)
};
constexpr int NPH = sizeof(SCHED);
static_assert(NPH == 35, "phase count");

__device__ __forceinline__ size_t blk_off(int row, int col) { return (size_t)(row >> 8) * (256 * 1024) + (size_t)(col >> 6) * (256 * 64) + (size_t)(row & 255) * 64 + (col & 63); }
__device__ __forceinline__ unsigned f2bf(float f) { unsigned u = __builtin_bit_cast(unsigned, f); return (u + 0x7fffu + ((u >> 16) & 1u)) >> 16; }
__device__ __forceinline__ unsigned pk2(float lo, float hi) { return f2bf(lo) | (f2bf(hi) << 16); }
__device__ __forceinline__ float bf_lo(unsigned w) { return __builtin_bit_cast(float, w << 16); }
__device__ __forceinline__ float bf_hi(unsigned w) { return __builtin_bit_cast(float, w & 0xffff0000u); }
__device__ __forceinline__ float wave_sum(float v) {
#pragma unroll
    for (int o = 1; o < 64; o <<= 1) v += __shfl_xor(v, o);
    return v;
}
__device__ __forceinline__ float silu_f(float a) { return a * __builtin_amdgcn_rcpf(1.0f + __builtin_amdgcn_exp2f(-1.44269504089f * a)); }

namespace pg8 {
typedef unsigned u32x2 __attribute__((ext_vector_type(2)));
struct EpiPair {
    static constexpr bool PERM = true, AFTER_DRAIN = false;
    bf16_t* O1; int ld1; bf16_t* O2; int ld2; int npair; const float* ssq; const float* sw; int N; int mode;
    __device__ __forceinline__ void operator()(const f32x4 (&acc)[2][2][4][2], const Unit& u, int wr, int wc, int fr, int fq) const {
        const int b = u.pm >> 5, row0 = u.pm * BM + wr * 64 + fr, cw = wc * 32 + 8 * fq;
        const float* swp = sw + (size_t)b * N + u.pn * BM + cw;
        f32x4 bv[2][2];
#pragma unroll
        for (int bj = 0; bj < 2; ++bj)
#pragma unroll
            for (int n = 0; n < 2; ++n) bv[bj][n] = *(const f32x4*)(swp + bj * HALF + 4 * n);
        float rsv[8];
        { f32x4 pv8[8];
#pragma unroll
          for (int rg = 0; rg < 8; ++rg) pv8[rg] = *(const f32x4*)(ssq + (size_t)(row0 + (rg >> 2) * HALF + (rg & 3) * 16) * 16 + 4 * fq);
#pragma unroll
          for (int rg = 0; rg < 8; ++rg) { float t = (pv8[rg][0] + pv8[rg][1]) + (pv8[rg][2] + pv8[rg][3]); t += __shfl_xor(t, 16); t += __shfl_xor(t, 32); rsv[rg] = __builtin_amdgcn_rsqf(t * (1.0f / 1024.0f) + 1e-5f); } }
        if (u.pn < npair) {
            bf16_t* base = mode == 0 ? O1 + (size_t)u.pm * ((size_t)BM * ld1) + (size_t)(2 * u.pn + (wc >> 1)) * (BM * 64) + 32 * (wc & 1) + 8 * fq : O1 + u.pn * HALF + cw;
            const int rstr = mode == 0 ? 64 : ld1, rsub = mode == 0 ? u.pm * BM : 0;
#pragma unroll
            for (int ai = 0; ai < 2; ++ai)
#pragma unroll
                for (int m = 0; m < 4; ++m) { const int r = row0 + ai * HALF + m * 16; const float rs = rsv[ai * 4 + m];
                    const f32x4 a0 = acc[ai][0][m][0] * rs + bv[0][0], a1 = acc[ai][0][m][1] * rs + bv[0][1], b0 = acc[ai][1][m][0] * rs + bv[1][0], b1 = acc[ai][1][m][1] * rs + bv[1][1];
                    f32x4 v0, v1;
                    if (mode == 0) {
#pragma unroll
                        for (int j = 0; j < 4; ++j) { v0[j] = silu_f(a0[j]) * b0[j]; v1[j] = silu_f(a1[j]) * b1[j]; }
                    } else { v0 = a0 * b0; v1 = a1 * b1; }
                    u32x4 w; w.x = cvt_pk_bf16(v0[0], v0[1]); w.y = cvt_pk_bf16(v0[2], v0[3]); w.z = cvt_pk_bf16(v1[0], v1[1]); w.w = cvt_pk_bf16(v1[2], v1[3]);
                    *(u32x4*)(base + (size_t)(r - rsub) * rstr) = w; }
        } else {
            bf16_t* base = O2 + (u.pn - npair) * BM + cw;
#pragma unroll
            for (int ai = 0; ai < 2; ++ai)
#pragma unroll
                for (int m = 0; m < 4; ++m) { const int r = row0 + ai * HALF + m * 16; const float rs = rsv[ai * 4 + m];
#pragma unroll
                    for (int bj = 0; bj < 2; ++bj) { const f32x4 v0 = acc[ai][bj][m][0] * rs + bv[bj][0], v1 = acc[ai][bj][m][1] * rs + bv[bj][1];
                        u32x4 w; w.x = cvt_pk_bf16(v0[0], v0[1]); w.y = cvt_pk_bf16(v0[2], v0[3]); w.z = cvt_pk_bf16(v1[0], v1[1]); w.w = cvt_pk_bf16(v1[2], v1[3]);
                        *(u32x4*)(base + (size_t)r * ld2 + bj * HALF) = w; } }
        }
    }
};
struct EpiRope {
    static constexpr bool PERM = true, AFTER_DRAIN = false;
    bf16_t* O1; bf16_t* O2; int nrope; float scale1; const float* ssq; const float* sw; int N; const float* cs;
    __device__ __forceinline__ void operator()(const f32x4 (&acc)[2][2][4][2], const Unit& u, int wr, int wc, int fr, int fq) const {
        const int b = u.pm >> 5, row0 = u.pm * BM + wr * 64 + fr, cw = wc * 32 + 8 * fq;
        const float* swp = sw + (size_t)b * N + u.pn * BM + cw;
        f32x4 bv[2][2];
#pragma unroll
        for (int bj = 0; bj < 2; ++bj)
#pragma unroll
            for (int n = 0; n < 2; ++n) bv[bj][n] = *(const f32x4*)(swp + bj * HALF + 4 * n);
        const bool rope = u.pn < nrope;
        bf16_t* const obase = rope ? O1 : O2; const int pnl = rope ? u.pn : u.pn - nrope, shd = 2 * (pnl >> 1), dimc = 32 * (wc & 1) + 8 * fq;
        const float sc = rope ? scale1 : 1.0f;
        const bool rw = rope && ((wc & 1) == 0);
        const float sgn = (fq == 0) ? -1.0f : 1.0f;
        float rsv[8];
        { f32x4 pv8[8];
#pragma unroll
          for (int rg = 0; rg < 8; ++rg) pv8[rg] = *(const f32x4*)(ssq + (size_t)(row0 + (rg >> 2) * HALF + (rg & 3) * 16) * 16 + 4 * fq);
#pragma unroll
          for (int rg = 0; rg < 8; ++rg) { float t = (pv8[rg][0] + pv8[rg][1]) + (pv8[rg][2] + pv8[rg][3]); t += __shfl_xor(t, 16); t += __shfl_xor(t, 32); rsv[rg] = __builtin_amdgcn_rsqf(t * (1.0f / 1024.0f) + 1e-5f); } }
#pragma unroll
        for (int ai = 0; ai < 2; ++ai)
#pragma unroll
            for (int m = 0; m < 4; ++m) { const int r = row0 + ai * HALF + m * 16;
                f32x4 c0 = (f32x4){1.f, 1.f, 1.f, 1.f}, c1 = c0, s0 = (f32x4){0.f, 0.f, 0.f, 0.f}, s1 = s0;
                if (rw && fq < 2) { const float* cp = cs + (size_t)r * 16; c0 = *(const f32x4*)(cp); c1 = *(const f32x4*)(cp + 4); s0 = *(const f32x4*)(cp + 8) * sgn; s1 = *(const f32x4*)(cp + 12) * sgn; }
                const float rs = rsv[ai * 4 + m];
#pragma unroll
                for (int bj = 0; bj < 2; ++bj) { f32x4 v0 = acc[ai][bj][m][0] * rs + bv[bj][0], v1 = acc[ai][bj][m][1] * rs + bv[bj][1];
                    if (rw) { f32x4 p0, p1;
#pragma unroll
                        for (int j = 0; j < 4; ++j) { p0[j] = __shfl_xor(v0[j], 16); p1[j] = __shfl_xor(v1[j], 16); }
                        v0 = v0 * c0 + p0 * s0; v1 = v1 * c1 + p1 * s1; }
                    v0 = v0 * sc; v1 = v1 * sc;
                    u32x4 w; w.x = cvt_pk_bf16(v0[0], v0[1]); w.y = cvt_pk_bf16(v0[2], v0[3]); w.z = cvt_pk_bf16(v1[0], v1[1]); w.w = cvt_pk_bf16(v1[2], v1[3]);
                    { const int head = 4 * pnl + 2 * bj + (wc >> 1), tt = r & 8191, chain = ((((r >> 13) * 24 + head) << shd) + (tt & ((1 << shd) - 1)));
                      *(u32x4*)(obase + ((size_t)chain << (19 - shd)) + ((tt >> shd) << 6) + dimc) = w; } } }
    }
};
struct EpiRes {
    static constexpr bool PERM = true, AFTER_DRAIN = false;
    bf16_t* x; const float* gate; const float* gs1; bf16_t* xs1; const float* gs2; bf16_t* xs2; float* ssq;
    __device__ __forceinline__ void operator()(const f32x4 (&acc)[2][2][4][2], const Unit& u, int wr, int wc, int fr, int fq) const {
        const int b = u.pm >> 5, row0 = u.pm * BM + wr * 64 + fr, cw = u.pn * BM + wc * 64 + 8 * fq;
        const size_t boff0 = (size_t)u.pm * (256 * 1024) + (size_t)(4 * u.pn + wc) * (256 * 64) + (size_t)(wr * 64 + fr) * 64 + 8 * fq;
        f32x4 gta[2], gtb[2], g1a[2], g1b[2];
#pragma unroll
        for (int bj = 0; bj < 2; ++bj) { const int colb = cw + bj * 32; gta[bj] = *(const f32x4*)(gate + b * 1024 + colb); gtb[bj] = *(const f32x4*)(gate + b * 1024 + colb + 4); g1a[bj] = *(const f32x4*)(gs1 + b * 1024 + colb); g1b[bj] = *(const f32x4*)(gs1 + b * 1024 + colb + 4); }
#pragma unroll
        for (int ai = 0; ai < 2; ++ai) { float ss4[4] = {0.f, 0.f, 0.f, 0.f};
            u32x4 xr1[2][4];
#pragma unroll
            for (int bj = 0; bj < 2; ++bj)
#pragma unroll
                for (int m = 0; m < 4; ++m) xr1[bj][m] = *(const u32x4*)(x + boff0 + 32 * bj + (size_t)(ai * HALF + m * 16) * 64);
#pragma unroll
        for (int bj = 0; bj < 2; ++bj) { const int colb = cw + bj * 32; const size_t boff = boff0 + 32 * bj;
#pragma unroll
            for (int m = 0; m < 4; ++m) { const size_t off = boff + (size_t)(ai * HALF + m * 16) * 64;
                const u32x4 xc = xr1[bj][m];
                const f32x4 xo0 = (f32x4){__builtin_bit_cast(float, xc.x << 16), __builtin_bit_cast(float, xc.x & 0xffff0000u), __builtin_bit_cast(float, xc.y << 16), __builtin_bit_cast(float, xc.y & 0xffff0000u)};
                const f32x4 xo1 = (f32x4){__builtin_bit_cast(float, xc.z << 16), __builtin_bit_cast(float, xc.z & 0xffff0000u), __builtin_bit_cast(float, xc.w << 16), __builtin_bit_cast(float, xc.w & 0xffff0000u)};
                const f32x4 xn0 = xo0 + gta[bj] * acc[ai][bj][m][0], xn1 = xo1 + gtb[bj] * acc[ai][bj][m][1];
                { u32x4 w; w.x = cvt_pk_bf16(xn0[0], xn0[1]); w.y = cvt_pk_bf16(xn0[2], xn0[3]); w.z = cvt_pk_bf16(xn1[0], xn1[1]); w.w = cvt_pk_bf16(xn1[2], xn1[3]); *(u32x4*)(x + off) = w; }
                ss4[m] += ((xn0[0] * xn0[0] + xn0[1] * xn0[1]) + (xn0[2] * xn0[2] + xn0[3] * xn0[3])) + ((xn1[0] * xn1[0] + xn1[1] * xn1[1]) + (xn1[2] * xn1[2] + xn1[3] * xn1[3]));
                if (xs1) { const f32x4 y0 = xn0 * g1a[bj], y1 = xn1 * g1b[bj]; u32x4 w; w.x = cvt_pk_bf16(y0[0], y0[1]); w.y = cvt_pk_bf16(y0[2], y0[3]); w.z = cvt_pk_bf16(y1[0], y1[1]); w.w = cvt_pk_bf16(y1[2], y1[3]); *(u32x4*)(xs1 + off) = w; }
                if (xs2) { const f32x4 y0 = xn0 * *(const f32x4*)(gs2 + b * 1024 + colb), y1 = xn1 * *(const f32x4*)(gs2 + b * 1024 + colb + 4); u32x4 w; w.x = cvt_pk_bf16(y0[0], y0[1]); w.y = cvt_pk_bf16(y0[2], y0[3]); w.z = cvt_pk_bf16(y1[0], y1[1]); w.w = cvt_pk_bf16(y1[2], y1[3]); *(u32x4*)(xs2 + off) = w; } }
            asm volatile("" ::: "memory"); }
#pragma unroll
            for (int m = 0; m < 4; ++m) { ss4[m] += __shfl_xor(ss4[m], 16); ss4[m] += __shfl_xor(ss4[m], 32); }
            const float mine = fq == 0 ? ss4[0] : fq == 1 ? ss4[1] : fq == 2 ? ss4[2] : ss4[3];
            ssq[(size_t)(row0 + ai * HALF + fq * 16) * 16 + u.pn * 4 + wc] = mine; }
    }
};
}

__device__ __forceinline__ int mapcol(int map, int n0) {
    if (map == 0) return n0;
    const int pn = n0 >> 8, jj = n0 & 255;
    if (map == 3) return 256 * pn + 64 * ((jj & 127) >> 5) + 32 * (jj >> 7) + (jj & 31);
    if (map == 1) return jj < 128 ? 128 * pn + jj : FF + 128 * pn + (jj - 128);
    if (pn < 8) return jj < 128 ? 1024 + 128 * pn + jj : 2048 + 128 * pn + (jj - 128);
    return 256 * (pn - 8) + jj;
}
__device__ __forceinline__ void transpose_item(const float* W, int K, int N, bf16* WT, int map, LAS float* scr, int item, int lane) {
    const int nblk = N / 64, kb = item / nblk, nb = item % nblk, k0 = 64 * kb, n0 = 64 * nb;
    const int t = lane & 31, sc = (t < 16 ? mapcol(map, n0) + 2 * t : mapcol(map, n0 + 32) + 2 * (t - 16));
    LAS unsigned char* sb = (LAS unsigned char*)scr;
    const float* wp = W + (size_t)(k0 + (lane >> 5)) * N + sc;
#pragma unroll 8
    for (int i = 0; i < 32; ++i) { const float2 v = *(const float2*)(wp + (size_t)(2 * i) * N); *(LAS unsigned*)(sb + (2 * i + (lane >> 5)) * 132 + 4 * t) = pk2(v.x, v.y); }
    asm volatile("s_waitcnt lgkmcnt(0)" ::: "memory");
    const int c = lane & 7, nn = lane >> 3;
#pragma unroll
    for (int j = 0; j < 8; ++j) { const int n = nn + 8 * j; const LAS unsigned char* sp = sb + (8 * c) * 132 + 2 * n;
        v4u o; o.x = (unsigned)*(const LAS unsigned short*)(sp) | ((unsigned)*(const LAS unsigned short*)(sp + 132) << 16); o.y = (unsigned)*(const LAS unsigned short*)(sp + 264) | ((unsigned)*(const LAS unsigned short*)(sp + 396) << 16);
        o.z = (unsigned)*(const LAS unsigned short*)(sp + 528) | ((unsigned)*(const LAS unsigned short*)(sp + 660) << 16); o.w = (unsigned)*(const LAS unsigned short*)(sp + 792) | ((unsigned)*(const LAS unsigned short*)(sp + 924) << 16);
        *(v4u*)(WT + (size_t)(n0 + n) * K + k0 + 8 * c) = o; }
    asm volatile("s_waitcnt lgkmcnt(0)" ::: "memory");
}
struct Params { const float* in[20]; float* out; unsigned char* ws; double inv[8]; int lo, hi; };

#define PIN(i) in_ptr(lds, i)
__device__ __forceinline__ const float* in_ptr(LAS unsigned char* lds, int i) { const unsigned long long v = ((const LAS unsigned long long*)(lds + 131072 + 1024))[i];
    const unsigned lo = __builtin_amdgcn_readfirstlane((unsigned)v), hi = __builtin_amdgcn_readfirstlane((unsigned)(v >> 32)); return (const float*)(const __attribute__((address_space(1))) float*)(((unsigned long long)hi << 32) | lo); }
__device__ __forceinline__ void convert_layer(LAS unsigned char* lds, int L, unsigned char* ws, LAS float* scr, int gw, int NGW, int lane) {
    constexpr int I_IN = 16 * (NFF2 / 64), I_OUT = (FF / 64) * 16, I_CIN = 16 * 48, I_COUT = 16 * 16, I_Q = 16 * 24, I_O = 8 * 16, I_KV = 16 * 48;
    const float* f1in = PIN(6) + (size_t)L * D * NFF2; const float* f1out = PIN(7) + (size_t)L * FF * D;
    const float* f2in = PIN(8) + (size_t)L * D * NFF2; const float* f2out = PIN(9) + (size_t)L * FF * D;
    const bool conv = L < 2; const int j = L - 2;
    const int i_mi = conv ? I_CIN : I_Q, i_mo = conv ? I_COUT : I_O, i_kv = (L == 2) ? I_KV : 0;
    const int total = 2 * I_IN + 2 * I_OUT + i_mi + i_mo + i_kv;
    for (int it = gw; it < total; it += NGW) {
        int r = it;
        if (r < I_IN) { transpose_item(f1in, D, NFF2, (bf16*)(ws + W_F1IN), 1, scr, r, lane); continue; } r -= I_IN;
        if (r < I_IN) { transpose_item(f2in, D, NFF2, (bf16*)(ws + W_F2IN), 1, scr, r, lane); continue; } r -= I_IN;
        if (r < I_OUT) { transpose_item(f1out, FF, D, (bf16*)(ws + W_F1OUT), 3, scr, r, lane); continue; } r -= I_OUT;
        if (r < I_OUT) { transpose_item(f2out, FF, D, (bf16*)(ws + W_F2OUT), 3, scr, r, lane); continue; } r -= I_OUT;
        if (r < i_mi) { if (conv) transpose_item(PIN(10) + (size_t)L * D * 3072, D, 3072, (bf16*)(ws + W_MXIN), 2, scr, r, lane);
                        else transpose_item(PIN(17) + (size_t)j * D * QW, D, QW, (bf16*)(ws + W_MXIN), 0, scr, r, lane); continue; } r -= i_mi;
        if (r < i_mo) { if (conv) transpose_item(PIN(12) + (size_t)L * D * D, D, D, (bf16*)(ws + W_MXOUT), 3, scr, r, lane);
                        else transpose_item(PIN(18) + (size_t)j * OW * D, OW, D, (bf16*)(ws + W_MXOUT), 3, scr, r, lane); continue; } r -= i_mo;
        transpose_item(PIN(16), D, 3072, (bf16*)(ws + W_KV), 0, scr, r, lane);
    }
}
__device__ __forceinline__ void swp_matrix(const bf16* Wt, int N, const float* sh, float* out, int gw, int NGW, int lane) {
    f32x4 s[4][4];
#pragma unroll
    for (int b = 0; b < 4; ++b)
#pragma unroll
        for (int j = 0; j < 2; ++j) { s[b][2 * j] = *(const f32x4*)(sh + b * 1024 + 512 * j + 8 * lane); s[b][2 * j + 1] = *(const f32x4*)(sh + b * 1024 + 512 * j + 8 * lane + 4); }
    for (int n = gw; n < N; n += NGW) {
        const v4u w0 = *(const v4u*)(Wt + (size_t)n * 1024 + 8 * lane), w1 = *(const v4u*)(Wt + (size_t)n * 1024 + 512 + 8 * lane);
        f32x4 x[4]; x[0] = (f32x4){bf_lo(w0.x), bf_hi(w0.x), bf_lo(w0.y), bf_hi(w0.y)}; x[1] = (f32x4){bf_lo(w0.z), bf_hi(w0.z), bf_lo(w0.w), bf_hi(w0.w)};
        x[2] = (f32x4){bf_lo(w1.x), bf_hi(w1.x), bf_lo(w1.y), bf_hi(w1.y)}; x[3] = (f32x4){bf_lo(w1.z), bf_hi(w1.z), bf_lo(w1.w), bf_hi(w1.w)};
        float a[4];
#pragma unroll
        for (int b = 0; b < 4; ++b) { f32x4 t = x[0] * s[b][0] + x[1] * s[b][1] + x[2] * s[b][2] + x[3] * s[b][3]; a[b] = wave_sum((t[0] + t[1]) + (t[2] + t[3])); }
        if (lane < 4) out[(size_t)lane * N + n] = lane == 0 ? a[0] : lane == 1 ? a[1] : lane == 2 ? a[2] : a[3];
    }
}
__device__ __forceinline__ void swp_layer(int L, unsigned char* wst, unsigned char* ws, int gw, int NGW, int lane) {
    const float* SH = (const float*)(wst + WS_TAB) + 13 * 4096; float* SW = (float*)(wst + WS_SW) + (L & 1) * SW_SZ;
    swp_matrix((const bf16*)(ws + W_F1IN), NFF2, SH + (3 * L + 0) * 4096, SW + SW_F1, gw, NGW, lane);
    swp_matrix((const bf16*)(ws + W_MXIN), L < 2 ? 3072 : QW, SH + (3 * L + 1) * 4096, SW + SW_MX, gw, NGW, lane);
    swp_matrix((const bf16*)(ws + W_F2IN), NFF2, SH + (3 * L + 2) * 4096, SW + SW_F2, gw, NGW, lane);
    if (L == 2) swp_matrix((const bf16*)(ws + W_KV), 3072, SH + 12 * 4096, SW + SW_KV, gw, NGW, lane);
}

constexpr int AT_KP = 144, AT_VP = 528, AT_VOFF = 256 * AT_KP;
struct AtUnit { int ib, d, r, g, h, rowb, hoff, cb; };
__device__ __forceinline__ AtUnit at_decode(int u) { AtUnit a; const int qb = u & 63, gb = u >> 9; a.h = (u >> 6) & 7; a.g = gb % 3; const int b = gb / 3, sh = 2 * a.g, nbk = 64 >> sh; a.d = 1 << sh; a.r = qb >> (6 - sh); a.ib = qb & (nbk - 1);
    a.hoff = (a.g * 8 + a.h) * 64; a.rowb = b * SEQ; a.cb = ((((b * 24 + a.g * 8 + a.h) << sh) + a.r) << (19 - sh)); return a; }
__device__ __forceinline__ void attn_phase(LAS unsigned char* lds, const bf16* Qb, const bf16* Kb, const bf16* Vb, bf16* og0, bf16* og1, bf16* og2, float* lse, int G, int wg, const int tid) {
    const int lane = tid & 63, w = __builtin_amdgcn_readfirstlane(tid >> 6), fr = lane & 15, kq = lane >> 4;
    constexpr int NU = NB * 3 * 8 * 64;
    const int per = (NU + G - 1) / G, u0 = wg * per, u1 = (u0 + per < NU) ? u0 + per : NU;
    if (u0 >= u1) return;
    const v4u z4 = (v4u){0u, 0u, 0u, 0u};
    const int kk0 = tid >> 3, kc = tid & 7, vjp = tid & 63, vc = tid >> 6;
    const int vkey = 2 * vjp, vpos = (vkey & ~31) + (((vkey >> 2) & 3) << 3) + (((vkey >> 4) & 1) << 2) + (vkey & 3);
    v4u rk0, rk1, rv0, rv1; bf16x8 rq0, rq1;
#define AT_LOAD_BLOCK(A, blk, K0, K1, V0, V1) do { const int t0_ = (A).cb + (blk) * 8192; \
        K0 = *(const v4u*)(Kb + (t0_ + kk0 * 64 + 8 * kc)); K1 = *(const v4u*)(Kb + (t0_ + (kk0 + 64) * 64 + 8 * kc)); \
        const bf16* vp_ = Vb + (t0_ + vkey * 64 + 8 * vc); V0 = *(const v4u*)vp_; V1 = *(const v4u*)(vp_ + 64); } while (0)
#define AT_STORE_BLOCK(slot, K0, K1, V0, V1) do { \
        *(LAS v4u*)(lds + ((slot) * 128 + kk0) * AT_KP + 16 * kc) = K0; *(LAS v4u*)(lds + ((slot) * 128 + kk0 + 64) * AT_KP + 16 * kc) = K1; \
        LAS unsigned char* vb_ = lds + AT_VOFF + (32 * (vc & 1) + 4 * (vc >> 1)) * AT_VP + ((slot) * 128 + vpos) * 2;     \
        *(LAS unsigned*)(vb_ + 0 * AT_VP) = (V0.x & 0xffffu) | (V1.x << 16); *(LAS unsigned*)(vb_ + 1 * AT_VP) = (V0.x >> 16) | (V1.x & 0xffff0000u); \
        *(LAS unsigned*)(vb_ + 2 * AT_VP) = (V0.y & 0xffffu) | (V1.y << 16); *(LAS unsigned*)(vb_ + 3 * AT_VP) = (V0.y >> 16) | (V1.y & 0xffff0000u); \
        *(LAS unsigned*)(vb_ + 16 * AT_VP) = (V0.z & 0xffffu) | (V1.z << 16); *(LAS unsigned*)(vb_ + 17 * AT_VP) = (V0.z >> 16) | (V1.z & 0xffff0000u); \
        *(LAS unsigned*)(vb_ + 18 * AT_VP) = (V0.w & 0xffffu) | (V1.w << 16); *(LAS unsigned*)(vb_ + 19 * AT_VP) = (V0.w >> 16) | (V1.w & 0xffff0000u); } while (0)
#define AT_LOAD_Q(A, Q0, Q1) do { const bf16* qp_ = Qb + ((A).cb + ((A).ib * 128 + 16 * w + fr) * 64 + 8 * kq); Q0 = *(const bf16x8*)qp_; Q1 = *(const bf16x8*)(qp_ + 32); } while (0)
    AtUnit cu = at_decode(u0);
    int ps = 0;
    __syncthreads();
    { v4u a0 = z4, a1 = z4, b0 = z4, b1 = z4; if (cu.ib > 0) AT_LOAD_BLOCK(cu, cu.ib - 1, a0, a1, b0, b1); AT_STORE_BLOCK(ps, a0, a1, b0, b1); }
    AT_LOAD_BLOCK(cu, cu.ib, rk0, rk1, rv0, rv1); AT_LOAD_Q(cu, rq0, rq1);
    for (int u = u0; u < u1; ++u) {
        const int cs = ps ^ 1;
        if (u > u0 && cu.ib == 0) AT_STORE_BLOCK(ps, z4, z4, z4, z4);
        AT_STORE_BLOCK(cs, rk0, rk1, rv0, rv1);
        const bf16x8 qf0 = rq0, qf1 = rq1;
        const AtUnit au = cu;
        __syncthreads();
        if (u + 1 < u1) { cu = at_decode(u + 1); AT_LOAD_BLOCK(cu, cu.ib, rk0, rk1, rv0, rv1); AT_LOAD_Q(cu, rq0, rq1); }
        const int qi = 16 * w + fr;
        const int qrow = au.rowb + (au.ib * 128 + qi) * au.d + au.r;
        int wv = w, psv = ps; asm volatile("" : "+v"(wv), "+v"(psv));
        const int G0 = 2 * (wv >> 1);
        f32x4 sc[10];
        {
            const LAS unsigned char* kb0 = lds + fr * AT_KP + 16 * kq;
#pragma unroll
            for (int hh = 0; hh < 2; ++hh) { bf16x8 kf[5][2];
#pragma unroll
                for (int g5 = 0; g5 < 5; ++g5) { const int Gp = (G0 + hh * 5 + g5) ^ (psv << 3); const LAS unsigned char* kp = kb0 + Gp * (16 * AT_KP); kf[g5][0] = *(const LAS bf16x8*)kp; kf[g5][1] = *(const LAS bf16x8*)(kp + 64); }
#pragma unroll
                for (int g5 = 0; g5 < 5; ++g5) { f32x4 a = (f32x4){0.f, 0.f, 0.f, 0.f};
                    a = __builtin_amdgcn_mfma_f32_16x16x32_bf16(kf[g5][0], qf0, a, 0, 0, 0); a = __builtin_amdgcn_mfma_f32_16x16x32_bf16(kf[g5][1], qf1, a, 0, 0, 0); sc[hh * 5 + g5] = a; } }
        }
        const int dl0 = 4 * kq - fr;
#define AT_MASK(ODD) do { _Pragma("unroll") for (int i = 0; i < 4; ++i) { if (dl0 + i < 0) sc[ODD][i] = -INFINITY; if (dl0 + i > 0) sc[8 + ODD][i] = -INFINITY; sc[(ODD) ? 0 : 9][i] = -INFINITY; } } while (0)
        if (w & 1) AT_MASK(1); else AT_MASK(0);
#undef AT_MASK
        if (au.ib == 0) {
#pragma unroll
            for (int gg = 0; gg < 8; ++gg) if (G0 + gg < 8) sc[gg] = (f32x4){-INFINITY, -INFINITY, -INFINITY, -INFINITY};
        }
        float mx = -INFINITY;
#pragma unroll
        for (int gg = 0; gg < 10; ++gg) mx = fmaxf(fmaxf(mx, fmaxf(sc[gg][0], sc[gg][1])), fmaxf(sc[gg][2], sc[gg][3]));
        mx = fmaxf(mx, __shfl_xor(mx, 16)); mx = fmaxf(mx, __shfl_xor(mx, 32));
        float den = 0.f;
#pragma unroll
        for (int gg = 0; gg < 10; ++gg)
#pragma unroll
            for (int i = 0; i < 4; ++i) { const float pv = __builtin_amdgcn_exp2f(sc[gg][i] - mx); sc[gg][i] = pv; den += pv; }
        den += __shfl_xor(den, 16); den += __shfl_xor(den, 32);
        f32x4 o[4];
#pragma unroll
        for (int nt = 0; nt < 4; ++nt) o[nt] = (f32x4){0.f, 0.f, 0.f, 0.f};
        {   const LAS unsigned char* vb0 = lds + AT_VOFF + fr * AT_VP + 16 * kq;
            bf16x8 vf[2][4];
#define AT_VLOAD(cc, buf) do { const int chp_ = ((wv >> 1) + (cc)) ^ (psv << 2); const LAS unsigned char* vp_ = vb0 + chp_ * 64; _Pragma("unroll") for (int nt = 0; nt < 4; ++nt) vf[buf][nt] = *(const LAS bf16x8*)(vp_ + nt * (16 * AT_VP)); } while (0)
            AT_VLOAD(0, 0);
#pragma unroll
            for (int cc = 0; cc < 5; ++cc) {
                if (cc < 4) AT_VLOAD(cc + 1, (cc + 1) & 1);
                v4u pw; pw.x = cvt_pk_bf16(sc[2 * cc][0], sc[2 * cc][1]); pw.y = cvt_pk_bf16(sc[2 * cc][2], sc[2 * cc][3]); pw.z = cvt_pk_bf16(sc[2 * cc + 1][0], sc[2 * cc + 1][1]); pw.w = cvt_pk_bf16(sc[2 * cc + 1][2], sc[2 * cc + 1][3]);
                const bf16x8 pb = __builtin_bit_cast(bf16x8, pw);
#pragma unroll
                for (int nt = 0; nt < 4; ++nt) o[nt] = __builtin_amdgcn_mfma_f32_16x16x32_bf16(vf[cc & 1][nt], pb, o[nt], 0, 0, 0); }
#undef AT_VLOAD
        }
        const float inv = 1.0f / den;
        bf16* og = (au.g == 0) ? og0 : (au.g == 1) ? og1 : og2;
        bf16* op = og + (qrow * OW + au.h * 64 + 16 * kq);
#pragma unroll
        for (int hh = 0; hh < 2; ++hh) { v4u wv; wv.x = cvt_pk_bf16(o[2 * hh][0] * inv, o[2 * hh][1] * inv); wv.y = cvt_pk_bf16(o[2 * hh][2] * inv, o[2 * hh][3] * inv);
            wv.z = cvt_pk_bf16(o[2 * hh + 1][0] * inv, o[2 * hh + 1][1] * inv); wv.w = cvt_pk_bf16(o[2 * hh + 1][2] * inv, o[2 * hh + 1][3] * inv); *(v4u*)(op + 8 * hh) = wv; }
        if (kq == 0) lse[(au.cb >> 6) + au.ib * 128 + qi] = (mx + __builtin_amdgcn_logf(den)) * 0.69314718056f;
        ps = cs;
        __syncthreads();
    }
#undef AT_LOAD_BLOCK
#undef AT_STORE_BLOCK
#undef AT_LOAD_Q
}

#define XB_TMO      128
#define XB_XCNT(j)  (256  + 64 * (j))
#define XB_XSUB(j)  (1280 + 64 * (j))
#define XB_XGEN(j)  (2304 + 64 * (j))
#define XB_TOP      3328
#define XB_TOPGEN   3392
#define XCD_BAR_WORDS 3456
#define XB_SPIN_CAP (1u << 18)

__device__ __forceinline__ unsigned xb_ld(unsigned* p)              { return __hip_atomic_load(p, __ATOMIC_RELAXED, __HIP_MEMORY_SCOPE_AGENT); }
__device__ __forceinline__ unsigned xb_add(unsigned* p, unsigned v) { return __hip_atomic_fetch_add(p, v, __ATOMIC_RELAXED, __HIP_MEMORY_SCOPE_AGENT); }
__device__ __forceinline__ unsigned xb_xcc_id() { return (unsigned)__builtin_amdgcn_s_getreg((3 << 11) | 20) & 0xFu; }
#define XB_SPIN(cond, bar) do { unsigned _sp = 0; while (cond) { __builtin_amdgcn_s_sleep(1); \
    if ((++_sp & 255u) == 0u) { if (xb_ld(&(bar)[XB_TMO])) break; if (_sp > XB_SPIN_CAP) { atomicAdd(&(bar)[XB_TMO], 1u); break; } } } } while (0)

struct XcdBarrier {
    unsigned* bar; unsigned x;
    volatile LAS unsigned* st;
};

__device__ __forceinline__ XcdBarrier xcd_barrier_post(unsigned* bar, volatile LAS unsigned* st) {
    XcdBarrier b; b.bar = bar; b.x = xb_xcc_id(); b.st = st;
    if (threadIdx.x == 0) (void)xb_add(&bar[XB_XCNT(b.x)], 1u);
    return b;
}
__device__ __forceinline__ void xcd_barrier_complete(unsigned* bar, unsigned x, unsigned& nloc, unsigned& nx) {
    const unsigned G = gridDim.x * gridDim.y * gridDim.z;
    unsigned sum, cnt, mine, sp = 0u;
    for (;;) {
        sum = 0u; cnt = 0u; mine = 0u;
#pragma unroll
        for (unsigned j = 0; j < 16; ++j) { const unsigned c = xb_ld(&bar[XB_XCNT(j)]); sum += c; cnt += (c > 0u) ? 1u : 0u; mine = (j == x) ? c : mine; }
        if (sum == G) break;
        __builtin_amdgcn_s_sleep(1);
        if ((++sp & 255u) == 0u) { if (xb_ld(&bar[XB_TMO])) break; if (sp > XB_SPIN_CAP) { atomicAdd(&bar[XB_TMO], 1u); break; } }
    }
    nloc = mine > 0u ? mine : 1u; nx = cnt > 0u ? cnt : 1u;
}

__device__ __forceinline__ void xcd_barrier(const XcdBarrier& b) {
    asm volatile("s_waitcnt vmcnt(0)" ::: "memory");
    __syncthreads();
    if (threadIdx.x == 0) {
        unsigned* bar = b.bar;
        __builtin_amdgcn_s_waitcnt(0);
        unsigned nloc = b.st[0], nx = b.st[1];
        if (nloc == 0u) { xcd_barrier_complete(bar, b.x, nloc, nx); b.st[0] = nloc; b.st[1] = nx; }
        const unsigned old = xb_add(&bar[XB_XSUB(b.x)], 1u);
        const unsigned gen = old / nloc;
        if (old + 1u == (gen + 1u) * nloc) {
            __builtin_amdgcn_fence(__ATOMIC_RELEASE, "agent");
            asm volatile("s_waitcnt vmcnt(0)" ::: "memory");
            const unsigned og = xb_add(&bar[XB_TOP], 1u);
            const unsigned tg = og / nx;
            if (og + 1u == (tg + 1u) * nx) xb_add(&bar[XB_TOPGEN], 1u);
            else XB_SPIN(xb_ld(&bar[XB_TOPGEN]) == tg, bar);
            __builtin_amdgcn_fence(__ATOMIC_ACQUIRE, "agent");
            xb_add(&bar[XB_XGEN(b.x)], 1u);
            asm volatile("s_waitcnt vmcnt(0)" ::: "memory");
        } else {
            XB_SPIN(xb_ld(&bar[XB_XGEN(b.x)]) == gen, bar);
            __builtin_amdgcn_fence(__ATOMIC_ACQUIRE, "agent");
            asm volatile("s_waitcnt vmcnt(0)" ::: "memory");
        }
    }
    __syncthreads();
}

__global__ void __launch_bounds__(512, 2) fwd_megakernel(Params p) {
    extern __shared__ __attribute__((aligned(16))) unsigned char smem[];
    cg::grid_group grid = cg::this_grid();
    LAS unsigned char* lds = (LAS unsigned char*)smem;
    {
        LAS unsigned long long* PT0 = (LAS unsigned long long*)(lds + 131072 + 1024);
        if (threadIdx.x == 0) {
#pragma unroll
            for (int i = 0; i < 20; ++i) PT0[i] = (unsigned long long)p.in[i];
#pragma unroll
            for (int i = 0; i < 8; ++i) PT0[20 + i] = __builtin_bit_cast(unsigned long long, p.inv[i]);
        }
        if (threadIdx.x < 2) ((LAS unsigned*)(lds + 131072 + 2048))[threadIdx.x] = 0u;
        __syncthreads();
    }
    (void)xcd_barrier_post((unsigned*)(p.ws + WS_CTL), (volatile LAS unsigned*)(lds + 131072 + 2048));
    for (int ph = p.lo; ph < p.hi; ++ph) {
        int tid = threadIdx.x; asm volatile("" : "+v"(tid));
        int bx = blockIdx.x; asm volatile("" : "+s"(bx));
        int G = gridDim.x; asm volatile("" : "+s"(G));
        unsigned long long ws_raw = (unsigned long long)p.ws; asm volatile("" : "+s"(ws_raw));
        unsigned char* ws = (unsigned char*)(__attribute__((address_space(1))) unsigned char*)ws_raw;
        const int lane = tid & 63, wave = __builtin_amdgcn_readfirstlane(tid >> 6);
        const int gw = bx * 8 + wave, NGW = G * 8, gt = bx * 512 + tid, NGT = G * 512;
        float* SUMSQ = (float*)(ws + WS_SUMSQ); float* CS = (float*)(ws + WS_CS); float* MODP = (float*)(ws + WS_MODP);
        float* GS = (float*)(ws + WS_TAB); float* SH = GS + 13 * 4096; float* GATE = SH + 13 * 4096;
        bf16* XS = (bf16*)(ws + WS_XS); bf16* HB = (bf16*)(ws + WS_H); bf16* X16 = (bf16*)(ws + WS_X16); unsigned char* OB = (unsigned char*)(__attribute__((address_space(1))) unsigned char*)(unsigned long long)p.out;
        LAS float* scr = (LAS float*)(lds + wave * 16384);
        const int op = SCHED[ph], type = op & 15, L = (op >> 4) & 3, sb = op >> 6;
        unsigned char* const wsw = (L & 1) ? OB + (WB1_OFF - WS_W) : ws;
        unsigned char* const wsn = (L & 1) ? ws : OB + (WB1_OFF - WS_W);
        float* const SW = (float*)(ws + WS_SW) + (L & 1) * SW_SZ;
        switch (type) {
        case PH_P0A: {
            LAS float* cond = (LAS float*)lds;
            for (int i = tid; i < 4096; i += 512) { const int b = i >> 10, k = i & 1023; const float cv = PIN(1)[i]; cond[k * 4 + b] = cv / (1.0f + __expf(-cv)); }
            __syncthreads();
            for (int it = gw; it < 608 * 8; it += NGW) { const int cgp = it >> 3, ks = it & 7; const float* W; int ldw;
                if (cgp < 576) { const int Lm = cgp / 144; W = PIN(4) + (size_t)Lm * D * 9216 + (cgp % 144) * 64 + lane; ldw = 9216; } else { W = PIN(14) + (cgp - 576) * 64 + lane; ldw = 2048; }
                W += (size_t)(ks * 128) * ldw; float a0 = 0.f, a1 = 0.f, a2 = 0.f, a3 = 0.f;
#pragma unroll 16
                for (int k = 0; k < 128; ++k) { const float wv = W[(size_t)k * ldw]; const f32x4 cv = *(const LAS f32x4*)(cond + (ks * 128 + k) * 4); a0 += wv * cv[0]; a1 += wv * cv[1]; a2 += wv * cv[2]; a3 += wv * cv[3]; }
                float* mp = MODP + (size_t)(ks * 4) * NMODCOL + cgp * 64 + lane; mp[0] = a0; mp[NMODCOL] = a1; mp[2 * NMODCOL] = a2; mp[3 * NMODCOL] = a3; }
            __syncthreads();
            convert_layer(lds, 0, wsw, scr, gw, NGW, lane);
            for (int i = gt; i < T * 8; i += NGT) { const int row = i >> 3, j = i & 7; const double rev = (double)((const int*)PIN(2))[row] * __builtin_bit_cast(double, ((const LAS unsigned long long*)(lds + 131072 + 1024))[20 + j]);
                const float frv = (float)(rev - __builtin_floor(rev)); CS[row * 16 + j] = __builtin_amdgcn_cosf(frv); CS[row * 16 + 8 + j] = __builtin_amdgcn_sinf(frv); }
        } break;
        case PH_P0B: {
            for (int i = gt; i < 13 * 4096; i += NGT) { const int s = i >> 12, b = (i >> 10) & 3, c = i & 1023;
                if (s < 12) { const int Lm = s / 3, sbm = s % 3; float m3[3];
#pragma unroll
                    for (int q = 0; q < 3; ++q) { const int idx = (3 * sbm + q) * 1024 + c; float a = PIN(5)[Lm * 9216 + idx];
#pragma unroll
                        for (int ks = 0; ks < 8; ++ks) a += MODP[(size_t)(ks * 4 + b) * NMODCOL + Lm * 9216 + idx]; m3[q] = a; }
                    SH[i] = m3[0]; GS[i] = PIN(3)[(Lm * 3 + sbm) * 1024 + c] * (1.0f + m3[1]); GATE[i] = (sbm == 1 ? 1.0f : 0.5f) * (1.0f + m3[2]);
                } else { float m2[2];
#pragma unroll
                    for (int q = 0; q < 2; ++q) { const int idx = q * 1024 + c; float a = PIN(15)[idx];
#pragma unroll
                        for (int ks = 0; ks < 8; ++ks) a += MODP[(size_t)(ks * 4 + b) * NMODCOL + 36864 + idx]; m2[q] = a; }
                    SH[i] = m2[0]; GS[i] = PIN(13)[c] * (1.0f + m2[1]); } }
        } break;
        case PH_P0C: {
            swp_layer(0, ws, wsw, gw, NGW, lane);
            for (int m = gw; m < T; m += NGW) { const f32x4* xr = (const f32x4*)(PIN(0) + (size_t)m * D) + lane; const f32x4* gr = (const f32x4*)(GS + (m >> 13) * 1024) + lane;
                f32x4 v[4]; float s = 0.f;
#pragma unroll
                for (int j = 0; j < 4; ++j) { v[j] = xr[64 * j]; s += (v[j][0] * v[j][0] + v[j][1] * v[j][1]) + (v[j][2] * v[j][2] + v[j][3] * v[j][3]); }
                s = wave_sum(s); if (lane < 16) SUMSQ[(size_t)m * 16 + lane] = lane == 0 ? s : 0.f;
                const size_t bo = blk_off(m, 4 * lane);
#pragma unroll
                for (int j = 0; j < 4; ++j) { const f32x4 y = v[j] * gr[64 * j]; v2u wv; wv.x = pk2(y[0], y[1]); wv.y = pk2(y[2], y[3]); *(v2u*)(XS + bo + (size_t)j * (4 * 256 * 64)) = wv; v2u xv; xv.x = pk2(v[j][0], v[j][1]); xv.y = pk2(v[j][2], v[j][3]); *(v2u*)(X16 + bo + (size_t)j * (4 * 256 * 64)) = xv; } }
        } break;
        case PH_PW: convert_layer(lds, L, wsw, scr, gw, NGW, lane); break;
        case PH_SWP: swp_layer(L, ws, wsw, gw, NGW, lane); break;
        case PH_PAIR: {
            const int s = 3 * L + sb; const bool ffn = sb != 1;
            pg8::Gemm g{XS, (const bf16*)(wsw + (sb == 0 ? W_F1IN : sb == 1 ? W_MXIN : W_F2IN)), T, ffn ? NFF2 : 3072, D, 1};
            pg8::StaticOrder S; S.init(g.M, g.N, G, bx);
            pg8::EpiPair E{ffn ? HB : (bf16*)(ws + WS_V1), ffn ? FF : D, (bf16*)(ws + WS_BG), D, ffn ? 22 : 8, SUMSQ, SW + (sb == 0 ? SW_F1 : sb == 1 ? SW_MX : SW_F2), g.N, ffn ? 0 : 1};
            pg8::gemm_phase<pg8::EpiPair, pg8::StaticOrder, true, true>(lds, g, S, E, tid);
        } break;
        case PH_RES: {
            const int s = 3 * L + sb; const bool ffn = sb != 1;
            pg8::Gemm g{ffn ? HB : (L < 2 ? (const bf16*)OB : (const bf16*)(ws + WS_MIX)), (const bf16*)(wsw + (sb == 0 ? W_F1OUT : sb == 1 ? W_MXOUT : W_F2OUT)), T, D, ffn ? FF : (L < 2 ? D : OW), ffn ? 1 : 0};
            pg8::StaticOrder S; S.init(g.M, g.N, G, bx);
            pg8::EpiRes E{X16, GATE + s * 4096, GS + (s < 11 ? s + 1 : 0) * 4096, s < 11 ? XS : nullptr, GS + 12 * 4096, s == 5 ? (bf16*)OB : nullptr, SUMSQ};
            pg8::gemm_phase<pg8::EpiRes, pg8::StaticOrder, true, true>(lds, g, S, E, tid);
            if (sb == 1 && L < 3) swp_layer(L + 1, ws, wsn, gw, NGW, lane);
        } break;
        case PH_ROPE: {
            const bool kv = sb == 1;
            pg8::Gemm g{kv ? (const bf16*)OB : XS, (const bf16*)(wsw + (kv ? W_KV : W_MXIN)), T, kv ? 3072 : QW, D, 1};
            pg8::StaticOrder S; S.init(g.M, g.N, G, bx);
            pg8::EpiRope E{kv ? (bf16*)(ws + WS_K) : (bf16*)(ws + WS_Q), (bf16*)(ws + WS_V), 6, kv ? 1.0f : 0.125f * 1.44269504089f, SUMSQ, SW + (kv ? SW_KV : SW_MX), g.N, CS};
            pg8::gemm_phase<pg8::EpiRope, pg8::StaticOrder, true, true>(lds, g, S, E, tid);
        } break;
        case PH_CONVEW: {
            const bf16* V1 = (const bf16*)(ws + WS_V1); const bf16* BG = (const bf16*)(ws + WS_BG); bf16* Y = (bf16*)OB; const float* cw = PIN(11) + L * 3 * D;
            for (int i = gt; i < T * 128; i += NGT) { const int row = i >> 7, c8 = (i & 127) * 8, sq = row & (SEQ - 1); const size_t off = (size_t)row * D + c8;
                const v4u z = (v4u){0u, 0u, 0u, 0u};
                const v4u v2 = *(const v4u*)(V1 + off), v1 = sq >= 1 ? *(const v4u*)(V1 + off - D) : z, v0 = sq >= 2 ? *(const v4u*)(V1 + off - 2 * D) : z, bg = *(const v4u*)(BG + off);
                const f32x4 w0a = *(const f32x4*)(cw + c8), w0b = *(const f32x4*)(cw + c8 + 4), w1a = *(const f32x4*)(cw + D + c8), w1b = *(const f32x4*)(cw + D + c8 + 4), w2a = *(const f32x4*)(cw + 2 * D + c8), w2b = *(const f32x4*)(cw + 2 * D + c8 + 4);
                v4u o;
                o.x = pk2(bf_lo(bg.x) * (w0a[0] * bf_lo(v0.x) + w1a[0] * bf_lo(v1.x) + w2a[0] * bf_lo(v2.x)), bf_hi(bg.x) * (w0a[1] * bf_hi(v0.x) + w1a[1] * bf_hi(v1.x) + w2a[1] * bf_hi(v2.x)));
                o.y = pk2(bf_lo(bg.y) * (w0a[2] * bf_lo(v0.y) + w1a[2] * bf_lo(v1.y) + w2a[2] * bf_lo(v2.y)), bf_hi(bg.y) * (w0a[3] * bf_hi(v0.y) + w1a[3] * bf_hi(v1.y) + w2a[3] * bf_hi(v2.y)));
                o.z = pk2(bf_lo(bg.z) * (w0b[0] * bf_lo(v0.z) + w1b[0] * bf_lo(v1.z) + w2b[0] * bf_lo(v2.z)), bf_hi(bg.z) * (w0b[1] * bf_hi(v0.z) + w1b[1] * bf_hi(v1.z) + w2b[1] * bf_hi(v2.z)));
                o.w = pk2(bf_lo(bg.w) * (w0b[2] * bf_lo(v0.w) + w1b[2] * bf_lo(v1.w) + w2b[2] * bf_lo(v2.w)), bf_hi(bg.w) * (w0b[3] * bf_hi(v0.w) + w1b[3] * bf_hi(v1.w) + w2b[3] * bf_hi(v2.w)));
                *(v4u*)(Y + off) = o; }
            __syncthreads(); convert_layer(lds, L + 1, wsn, scr, gw, NGW, lane);
        } break;
        case PH_ATTN:
            attn_phase(lds, (const bf16*)(ws + WS_Q), (const bf16*)(ws + WS_K), (const bf16*)(ws + WS_V), (bf16*)OB, (bf16*)(OB + 32 * MiB), (bf16*)(ws + WS_OG2), (float*)(ws + WS_LSE), G, bx, tid);
            if (L == 2) { __syncthreads(); convert_layer(lds, 3, wsn, scr, gw, NGW, lane); }
            break;
        case PH_MERGE: {
            const bf16* o0 = (const bf16*)OB; const bf16* o1 = (const bf16*)(OB + 32 * MiB); const bf16* o2 = (const bf16*)(ws + WS_OG2); const float* lse = (const float*)(ws + WS_LSE); bf16* MIX = (bf16*)(ws + WS_MIX);
            for (int i = gt; i < T * 64; i += NGT) { const int row = i >> 6, c8 = (i & 63) * 8, h = c8 >> 6; const size_t off = (size_t)row * OW + c8;
                const int tt = row & 8191, bh = (row >> 13) * 24 + h;
                const float l0 = lse[(size_t)bh * 8192 + tt], l1 = lse[(size_t)((((bh + 8) << 2) + (tt & 3)) * 2048) + (tt >> 2)], l2 = lse[(size_t)((((bh + 16) << 4) + (tt & 15)) * 512) + (tt >> 4)];
                const float ml = fmaxf(l0, fmaxf(l1, l2)); float e0 = __expf(l0 - ml), e1 = __expf(l1 - ml), e2 = __expf(l2 - ml); const float is = 1.0f / (e0 + e1 + e2); e0 *= is; e1 *= is; e2 *= is;
                const v4u a = *(const v4u*)(o0 + off), bq = *(const v4u*)(o1 + off), cq = *(const v4u*)(o2 + off); v4u o;
                o.x = pk2(e0 * bf_lo(a.x) + e1 * bf_lo(bq.x) + e2 * bf_lo(cq.x), e0 * bf_hi(a.x) + e1 * bf_hi(bq.x) + e2 * bf_hi(cq.x));
                o.y = pk2(e0 * bf_lo(a.y) + e1 * bf_lo(bq.y) + e2 * bf_lo(cq.y), e0 * bf_hi(a.y) + e1 * bf_hi(bq.y) + e2 * bf_hi(cq.y));
                o.z = pk2(e0 * bf_lo(a.z) + e1 * bf_lo(bq.z) + e2 * bf_lo(cq.z), e0 * bf_hi(a.z) + e1 * bf_hi(bq.z) + e2 * bf_hi(cq.z));
                o.w = pk2(e0 * bf_lo(a.w) + e1 * bf_lo(bq.w) + e2 * bf_lo(cq.w), e0 * bf_hi(a.w) + e1 * bf_hi(bq.w) + e2 * bf_hi(cq.w));
                *(v4u*)(MIX + off) = o; }
        } break;
        case PH_FINAL: {
            const float* ssq = SUMSQ; const float* fg = PIN(19); float* OUT = (float*)OB;
            for (int i = gt; i < T * 128; i += NGT) { const int row = i >> 7, c8 = (i & 127) * 8; const f32x4* pp = (const f32x4*)(ssq + (size_t)row * 16); float tq = 0.f;
#pragma unroll
                for (int q = 0; q < 4; ++q) { const f32x4 pq = pp[q]; tq += (pq[0] + pq[1]) + (pq[2] + pq[3]); }
                const float rs = 1.0f / sqrtf(tq * (1.0f / 1024.0f) + EPS);
                const v4u xw = *(const v4u*)(X16 + blk_off(row, c8)); const f32x4 ga = *(const f32x4*)(fg + c8), gb = *(const f32x4*)(fg + c8 + 4);
                f32x4 oa = (f32x4){bf_lo(xw.x), bf_hi(xw.x), bf_lo(xw.y), bf_hi(xw.y)} * rs * ga, ob = (f32x4){bf_lo(xw.z), bf_hi(xw.z), bf_lo(xw.w), bf_hi(xw.w)} * rs * gb;
                float* op = OUT + (size_t)row * D + c8; *(f32x4*)op = oa; *(f32x4*)(op + 4) = ob; }
        } break;
        default: break;
        }
        if (ph + 1 < p.hi) { if (ph == p.lo) grid.sync(); else { XcdBarrier xb_; xb_.bar = (unsigned*)(ws + WS_CTL); xb_.x = xb_xcc_id(); xb_.st = (volatile LAS unsigned*)(lds + 131072 + 2048); xcd_barrier(xb_); } }
    }
}

extern "C" void kernel_launch(void* const* d_in, const int* in_sizes, int n_in, void* d_out, int out_size, void* d_ws, size_t ws_size, hipStream_t stream) {
    static int grid = 0;
    if (grid == 0) {
        if (n_in != 20 || out_size != T * D || ws_size < WS_END) { fprintf(stderr, "kernel_launch: unexpected shapes (n_in %d, out %d, ws %zu, need %zu)\n", n_in, out_size, ws_size, (size_t)WS_END); grid = -1; return; }
        int dev = 0, cus = 0, per_cu = 0;
        hipGetDevice(&dev); hipDeviceGetAttribute(&cus, hipDeviceAttributeMultiprocessorCount, dev);
        if (hipFuncSetAttribute((const void*)fwd_megakernel, hipFuncAttributeMaxDynamicSharedMemorySize, LDS_BYTES) != hipSuccess) { fprintf(stderr, "kernel_launch: hipFuncSetAttribute failed\n"); grid = -1; return; }
        if (hipOccupancyMaxActiveBlocksPerMultiprocessor(&per_cu, (const void*)fwd_megakernel, 512, LDS_BYTES) != hipSuccess || per_cu < 1) { fprintf(stderr, "kernel_launch: occupancy query says %d\n", per_cu); per_cu = 1; }
        (void)hipGetLastError();
        grid = cus * 1;
        fprintf(stderr, "kernel_launch: grid %d (occupancy query %d per CU), ws %zu\n", grid, per_cu, ws_size);
    }
    if (grid < 0) return;
    Params p{};
    for (int i = 0; i < 20; ++i) p.in[i] = (const float*)d_in[i];
    p.out = (float*)d_out; p.ws = (unsigned char*)d_ws;
    for (int j = 0; j < 8; ++j) p.inv[j] = pow(500000.0, -(double)j / 8.0) / 6.283185307179586476925286766559;
#if MK_PER_PHASE
    for (int ph = 0; ph < NPH; ++ph) { p.lo = ph; p.hi = ph + 1; void* args[] = {&p};
        hipError_t e = hipLaunchCooperativeKernel((const void*)fwd_megakernel, dim3(grid), dim3(512), args, LDS_BYTES, stream);
        if (e != hipSuccess) { fprintf(stderr, "launch %d failed: %s\n", ph, hipGetErrorString(e)); break; } }
#else
    if (hipMemsetAsync((char*)d_ws + WS_CTL, 0, CTL_BYTES, stream) != hipSuccess) { fprintf(stderr, "kernel_launch: memset failed\n"); return; }
    p.lo = 0; p.hi = NPH; void* args[] = {&p};
    hipError_t e = hipLaunchCooperativeKernel((const void*)fwd_megakernel, dim3(grid), dim3(512), args, LDS_BYTES, stream);
    if (e != hipSuccess) fprintf(stderr, "cooperative launch failed: %s (grid %d)\n", hipGetErrorString(e), grid);
#endif
}
```

```cpp
#include <hip/hip_runtime.h>
#include <hip/hip_cooperative_groups.h>
#include <cstdio>
#include <cstdint>
#include <cmath>
namespace cg = cooperative_groups;
namespace pg8 {
#define PG8_LAS __attribute__((address_space(3)))
typedef unsigned short bf16_t;
typedef short bf16x8 __attribute__((ext_vector_type(8)));
typedef float f32x4 __attribute__((ext_vector_type(4)));
typedef unsigned u32x4 __attribute__((ext_vector_type(4)));
constexpr int BM = 256, BK = 64, HALF = 128, HTB = HALF * BK * 2  , STAGE_BYTES = 8 * HTB, NXCD = 8, WGM = 8;

__host__ __device__ __forceinline__ int lds_byte(int r, int c) { const int st = (r >> 4) * 2 + (c >> 5), rr = r & 15, cc = c & 31, ob = rr * 64 + cc * 2; return st * 1024 + (ob ^ (((ob >> 9) & 1) << 5)); }
__host__ __device__ __forceinline__ void stage_rc(int b, int& R, int& C) { const int st = b / 1024, sb = b % 1024, swz = sb ^ (((sb >> 9) & 1) << 5); R = (st >> 1) * 16 + swz / 64; C = (st & 1) * 32 + (swz % 64) / 2; }
__host__ __device__ __forceinline__ int perm32(int rho) { const int n = rho >> 4, i = rho & 15; return 8 * (i >> 2) + 4 * n + (i & 3); }

struct Unit { int pm, pn; };
struct Gemm { const bf16_t* A; const bf16_t* Bt; int M, N, K; int ablk; };

struct StaticOrder {
    int nM, nN, nwg, G, c;
    __host__ __device__ void init(int M, int N, int G_, int c_) { nM = M / BM; nN = N / BM; nwg = nM * nN; G = G_; c = c_; }
    __host__ __device__ bool next(int i, Unit& u) const {
        const long L = (long)i * G + c; if (L >= nwg) return false;
        int wgid = (int)L; { const int q = nwg / NXCD, r = nwg % NXCD, xcd = wgid % NXCD, off = wgid / NXCD; wgid = (xcd < r ? xcd * (q + 1) : r * (q + 1) + (xcd - r) * q) + off; }
        const int nig = WGM * nN, gid = wgid / nig, fm = gid * WGM, gsz = (nM - fm) < WGM ? (nM - fm) : WGM;
        u.pm = fm + ((wgid % nig) % gsz); u.pn = (wgid % nig) / gsz; return true;
    }
    __device__ __forceinline__ void a_ready(const Unit&) const {}
    __device__ __forceinline__ void done(const Unit&) const {}
};
__device__ __forceinline__ unsigned cvt_pk_bf16(float lo, float hi) { unsigned r; asm volatile("v_cvt_pk_bf16_f32 %0, %1, %2" : "=v"(r) : "v"(lo), "v"(hi)); return r; }
template <class Epi, class Sched, bool ALIGN_EPI = false, bool SP2 = false>
__device__ __forceinline__ void gemm_phase(PG8_LAS unsigned char* lds, const Gemm g, const Sched& S, const Epi& E, const int tid) {
    const int wid = __builtin_amdgcn_readfirstlane(tid >> 6), lane = tid & 63, wr = wid >> 2, wc = wid & 3, fr = lane & 15, fq = lane >> 4;
    const int K = g.K, nt = K / BK;
    unsigned voffA[2], voffB[2];
#pragma unroll
    for (int i = 0; i < 2; ++i) { int R, C; stage_rc(tid * 16 + i * 8192, R, C); const int Rb = Epi::PERM ? ((R & ~31) + perm32(R & 31)) : R;
        voffA[i] = g.ablk ? (unsigned)(R * 64 + C) * 2u : (unsigned)(R * K + C) * 2u; voffB[i] = (unsigned)(Rb * K + C) * 2u; }
    const size_t kstep = (size_t)(BK * 2);
    const size_t hstep = (size_t)HALF * K * 2;
    const size_t tstep = 2 * hstep;
    const size_t kstepA = g.ablk ? (size_t)32768 : kstep, hstepA = g.ablk ? (size_t)16384 : hstep;
    const unsigned ldsw = (unsigned)wid * 1024u;
    const int aoff = lds_byte(wr * 64 + fr, fq * 8), boff = lds_byte(wc * 32 + fr, fq * 8);
#define PG8_SA(b, h) (((b) * 2 + (h)) * HTB)
#define PG8_SB(b, h) ((4 + (b) * 2 + (h)) * HTB)
#define PG8_STAGE(bufoff, gbase, voff) do { _Pragma("unroll") for (int _i = 0; _i < 2; ++_i) \
        __builtin_amdgcn_global_load_lds((const unsigned*)((const char*)(gbase) + (voff)[_i]), (PG8_LAS unsigned*)(lds + (bufoff) + ldsw + _i * 8192), 16, 0, 0); } while (0)
#define PG8_LDA(dst, b, h) do { _Pragma("unroll") for (int m = 0; m < 4; ++m) _Pragma("unroll") for (int k = 0; k < 2; ++k) dst[m][k] = *(const PG8_LAS bf16x8*)(lds + PG8_SA(b, h) + aoff + m * 2048 + k * 1024); } while (0)
#define PG8_LDB(dst, b, h) do { _Pragma("unroll") for (int n = 0; n < 2; ++n) _Pragma("unroll") for (int k = 0; k < 2; ++k) dst[n][k] = *(const PG8_LAS bf16x8*)(lds + PG8_SB(b, h) + boff + n * 2048 + k * 1024); } while (0)
#define PG8_MMA(ai, bj, At, Bt) do { __builtin_amdgcn_s_setprio(1); _Pragma("unroll") for (int m = 0; m < 4; ++m) _Pragma("unroll") for (int n = 0; n < 2; ++n) _Pragma("unroll") for (int k = 0; k < 2; ++k) \
        acc[ai][bj][m][n] = __builtin_amdgcn_mfma_f32_16x16x32_bf16(Bt[n][k], At[m][k], acc[ai][bj][m][n], 0, 0, 0); __builtin_amdgcn_s_setprio(0); } while (0)
#define PG8_WAIT_V(n) asm volatile("s_waitcnt vmcnt(" #n ")" ::: "memory")
#define PG8_WAIT_L(n) asm volatile("s_waitcnt lgkmcnt(" #n ")" ::: "memory")
#define PG8_BAR __builtin_amdgcn_s_barrier()
#define PG8_SCHED __builtin_amdgcn_sched_barrier(0)
    Unit cur, nxt; int ui = 0;
    if (!S.next(0, cur)) return;
    f32x4 acc[2][2][4][2];
#pragma unroll
    for (int a = 0; a < 2; ++a)
#pragma unroll
        for (int b = 0; b < 2; ++b)
#pragma unroll
            for (int m = 0; m < 4; ++m)
#pragma unroll
                for (int n = 0; n < 2; ++n) acc[a][b][m][n] = (f32x4){0.f, 0.f, 0.f, 0.f};
    bf16x8 At[4][2], B0[2][2], B1[2][2];
    const char* cA = (const char*)g.A + (size_t)cur.pm * tstep; const char* cB = (const char*)g.Bt + (size_t)cur.pn * tstep;
    S.a_ready(cur);
    if constexpr (SP2) {
        PG8_STAGE(PG8_SB(0, 0), cB, voffB); PG8_STAGE(PG8_SB(0, 1), cB + hstep, voffB); PG8_STAGE(PG8_SA(0, 0), cA, voffA); PG8_STAGE(PG8_SA(0, 1), cA + hstepA, voffA);
        if (wr == 1) PG8_BAR;
        PG8_WAIT_V(2); PG8_BAR;
        PG8_STAGE(PG8_SB(1, 0), cB + kstep, voffB); PG8_STAGE(PG8_SA(1, 0), cA + kstepA, voffA); PG8_STAGE(PG8_SB(1, 1), cB + hstep + kstep, voffB);
        PG8_WAIT_V(6); PG8_BAR;
    } else {
        PG8_STAGE(PG8_SB(0, 0), cB, voffB); PG8_STAGE(PG8_SA(0, 0), cA, voffA); PG8_STAGE(PG8_SB(0, 1), cB + hstep, voffB); PG8_STAGE(PG8_SA(0, 1), cA + hstepA, voffA);
        if (wr == 1) PG8_BAR;
        PG8_WAIT_V(4); PG8_BAR;
        PG8_STAGE(PG8_SB(1, 0), cB + kstep, voffB); PG8_STAGE(PG8_SA(1, 0), cA + kstepA, voffA); PG8_STAGE(PG8_SB(1, 1), cB + hstep + kstep, voffB);
        PG8_WAIT_V(6); PG8_BAR;
    }
    for (;;) {
        const bool has_next = S.next(ui + 1, nxt);
        const char* nA = has_next ? (const char*)g.A + (size_t)nxt.pm * tstep : cA; const char* nB = has_next ? (const char*)g.Bt + (size_t)nxt.pn * tstep : cB;
        for (int t = 0; t < nt; t += 2) {
            const bool last = (t == nt - 2);
            const char* a1 = cA + (size_t)(t + 1) * kstepA;
            const char* a2 = last ? nA : cA + (size_t)(t + 2) * kstepA; const char* b2 = last ? nB : cB + (size_t)(t + 2) * kstep;
            const char* a3 = a2 + kstepA; const char* b3 = b2 + kstep;
            if (last && has_next) S.a_ready(nxt);
            if constexpr (SP2) {
            PG8_LDB(B0, 0, 0); PG8_LDB(B1, 0, 1); PG8_SCHED; PG8_LDA(At, 0, 0); PG8_STAGE(PG8_SA(1, 1), a1 + hstepA, voffA);
            PG8_WAIT_V(8); PG8_WAIT_L(0); PG8_BAR; PG8_MMA(0, 0, At, B0); PG8_MMA(0, 1, At, B1); PG8_BAR; PG8_SCHED;
            PG8_LDA(At, 0, 1); PG8_STAGE(PG8_SB(0, 0), b2, voffB); PG8_STAGE(PG8_SB(0, 1), b2 + hstep, voffB); PG8_STAGE(PG8_SA(0, 0), a2, voffA);
            PG8_WAIT_V(8); PG8_WAIT_L(0); PG8_BAR; PG8_MMA(1, 0, At, B0); PG8_MMA(1, 1, At, B1); PG8_BAR; PG8_SCHED;
            PG8_LDB(B0, 1, 0); PG8_LDB(B1, 1, 1); PG8_SCHED; PG8_LDA(At, 1, 0); PG8_STAGE(PG8_SA(0, 1), a2 + hstepA, voffA);
            PG8_WAIT_V(8); PG8_WAIT_L(0); PG8_BAR; PG8_MMA(0, 0, At, B0); PG8_MMA(0, 1, At, B1); PG8_BAR; PG8_SCHED;
            PG8_LDA(At, 1, 1); PG8_STAGE(PG8_SB(1, 0), b3, voffB); PG8_STAGE(PG8_SB(1, 1), b3 + hstep, voffB); PG8_STAGE(PG8_SA(1, 0), a3, voffA);
            PG8_WAIT_V(8); PG8_WAIT_L(0); PG8_BAR; PG8_MMA(1, 0, At, B0); PG8_MMA(1, 1, At, B1); PG8_BAR; PG8_SCHED;
            } else {
            PG8_LDB(B0, 0, 0); PG8_SCHED; PG8_LDA(At, 0, 0); PG8_STAGE(PG8_SA(1, 1), a1 + hstepA, voffA);
            PG8_WAIT_L(8); PG8_BAR; PG8_WAIT_L(0); PG8_MMA(0, 0, At, B0); PG8_BAR; PG8_SCHED;
            PG8_LDB(B1, 0, 1); PG8_STAGE(PG8_SB(0, 0), b2, voffB);
            PG8_BAR; PG8_WAIT_L(0); PG8_MMA(0, 1, At, B1); PG8_BAR;
            PG8_LDA(At, 0, 1); PG8_STAGE(PG8_SA(0, 0), a2, voffA);
            PG8_BAR; PG8_WAIT_L(0); PG8_MMA(1, 0, At, B0); PG8_BAR; PG8_SCHED;
            PG8_STAGE(PG8_SB(0, 1), b2 + hstep, voffB);
            PG8_WAIT_V(6); PG8_BAR; PG8_MMA(1, 1, At, B1); PG8_BAR;
            PG8_LDB(B0, 1, 0); PG8_SCHED; PG8_LDA(At, 1, 0); PG8_STAGE(PG8_SA(0, 1), a2 + hstepA, voffA);
            PG8_WAIT_L(8); PG8_BAR; PG8_WAIT_L(0); PG8_MMA(0, 0, At, B0); PG8_BAR; PG8_SCHED;
            PG8_LDB(B1, 1, 1); PG8_STAGE(PG8_SB(1, 0), b3, voffB);
            PG8_BAR; PG8_WAIT_L(0); PG8_MMA(0, 1, At, B1); PG8_BAR;
            PG8_LDA(At, 1, 1); PG8_STAGE(PG8_SA(1, 0), a3, voffA);
            PG8_BAR; PG8_WAIT_L(0); PG8_MMA(1, 0, At, B0); PG8_BAR; PG8_SCHED;
            PG8_STAGE(PG8_SB(1, 1), b3 + hstep, voffB);
            PG8_WAIT_V(6); PG8_BAR; PG8_MMA(1, 1, At, B1); PG8_BAR;
            }
        }
        if constexpr (ALIGN_EPI) { if (wr == 0) PG8_BAR; }
        if constexpr (!Epi::AFTER_DRAIN) { E(acc, cur, wr, wc, fr, fq); S.done(cur); }
        if (!has_next) break;
#pragma unroll
        for (int a = 0; a < 2; ++a)
#pragma unroll
            for (int b = 0; b < 2; ++b)
#pragma unroll
                for (int m = 0; m < 4; ++m)
#pragma unroll
                    for (int n = 0; n < 2; ++n) acc[a][b][m][n] = (f32x4){0.f, 0.f, 0.f, 0.f};
        cur = nxt; cA = nA; cB = nB; ++ui;
        if constexpr (ALIGN_EPI) { if (wr == 1) PG8_BAR; }
    }
    PG8_WAIT_V(0);
    if constexpr (!ALIGN_EPI) { if (wr == 0) PG8_BAR; }
    PG8_BAR;
    if constexpr (Epi::AFTER_DRAIN) { E.fused(acc, cur, wr, wc, fr, fq, lds, wid, lane); S.done(cur); }
#undef PG8_SA
#undef PG8_SB
#undef PG8_STAGE
#undef PG8_LDA
#undef PG8_LDB
#undef PG8_MMA
#undef PG8_WAIT_V
#undef PG8_WAIT_L
#undef PG8_BAR
#undef PG8_SCHED
}
}

#ifndef MK_PER_PHASE
#define MK_PER_PHASE 0
#endif

#define LAS __attribute__((address_space(3)))
typedef unsigned short bf16;
typedef unsigned v4u __attribute__((ext_vector_type(4)));
typedef unsigned v2u __attribute__((ext_vector_type(2)));
typedef float f32x4 __attribute__((ext_vector_type(4)));
typedef short bf16x8 __attribute__((ext_vector_type(8)));
using pg8::cvt_pk_bf16;

constexpr int NB = 4, SEQ = 8192, D = 1024, T = NB * SEQ, FF = 2816, NFF2 = 2 * FF, QW = 1536, OW = 512;
constexpr float EPS = 1e-5f;
constexpr int NMODCOL = 4 * 9216 + 2048;

constexpr size_t MiB = 1u << 20;
constexpr size_t WS_SUMSQ = 557 * MiB;
constexpr size_t WS_CS    = 2 * MiB;
constexpr size_t WS_MODP  = 4 * MiB;
constexpr size_t WS_TAB   = 9 * MiB;
constexpr size_t WS_SW    = 10 * MiB;
constexpr size_t WS_W     = 11 * MiB;
constexpr size_t W_F1IN = WS_W, W_F1OUT = W_F1IN + 11 * MiB, W_F2IN = W_F1OUT + 6 * MiB, W_F2OUT = W_F2IN + 11 * MiB, W_MXIN = W_F2OUT + 6 * MiB, W_MXOUT = W_MXIN + 6 * MiB, W_KV = W_MXOUT + 2 * MiB;
constexpr size_t WS_XS    = 60 * MiB;
constexpr size_t WS_H     = 124 * MiB;
constexpr size_t WS_V1 = WS_H, WS_BG = WS_H + 64 * MiB;
constexpr size_t WS_Q = WS_H, WS_OG2 = WS_H + 96 * MiB, WS_MIX = WS_H + 128 * MiB, WS_LSE = WS_H + 160 * MiB;
constexpr size_t WS_K     = 300 * MiB;
constexpr size_t WS_V     = 396 * MiB;
constexpr size_t WS_X16   = 492 * MiB;
constexpr size_t WS_CTL   = 556 * MiB;
constexpr size_t CTL_BYTES = 65536;
constexpr size_t WS_END   = 561 * MiB;
static_assert(W_KV + 6 * MiB <= WS_XS, "weights");
constexpr int SW_F1 = 0, SW_MX = 4 * NFF2, SW_F2 = SW_MX + 4 * 3072, SW_KV = SW_F2 + 4 * NFF2, SW_SZ = SW_KV + 4 * 3072;
constexpr size_t WB1_OFF = 64 * MiB;

constexpr int LDS_BYTES = 147456;

enum { PH_P0A = 0, PH_P0B, PH_P0C, PH_PW, PH_SWP, PH_PAIR, PH_RES, PH_ROPE, PH_CONVEW, PH_ATTN, PH_MERGE, PH_FINAL };
#define OP(t, L, sb) (unsigned char)((t) | ((L) << 4) | ((sb) << 6))
__constant__ unsigned char SCHED[] = {
    OP(PH_P0A, 0, 0), OP(PH_P0B, 0, 0), OP(PH_P0C, 0, 0),
    OP(PH_PAIR, 0, 0), OP(PH_RES, 0, 0), OP(PH_PAIR, 0, 1), OP(PH_CONVEW, 0, 0), OP(PH_RES, 0, 1), OP(PH_PAIR, 0, 2), OP(PH_RES, 0, 2),
    OP(PH_PAIR, 1, 0), OP(PH_RES, 1, 0), OP(PH_PAIR, 1, 1), OP(PH_CONVEW, 1, 0), OP(PH_RES, 1, 1), OP(PH_PAIR, 1, 2), OP(PH_RES, 1, 2),
    OP(PH_ROPE, 2, 1),
    OP(PH_PAIR, 2, 0), OP(PH_RES, 2, 0), OP(PH_ROPE, 2, 0), OP(PH_ATTN, 2, 0), OP(PH_MERGE, 2, 0), OP(PH_RES, 2, 1), OP(PH_PAIR, 2, 2), OP(PH_RES, 2, 2),
    OP(PH_PAIR, 3, 0), OP(PH_RES, 3, 0), OP(PH_ROPE, 3, 0), OP(PH_ATTN, 3, 0), OP(PH_MERGE, 3, 0), OP(PH_RES, 3, 1), OP(PH_PAIR, 3, 2), OP(PH_RES, 3, 2),
    OP(PH_FINAL, 0, 0)
};
constexpr int NPH = sizeof(SCHED);
static_assert(NPH == 35, "phase count");

__device__ __forceinline__ size_t blk_off(int row, int col) { return (size_t)(row >> 8) * (256 * 1024) + (size_t)(col >> 6) * (256 * 64) + (size_t)(row & 255) * 64 + (col & 63); }
__device__ __forceinline__ unsigned f2bf(float f) { unsigned u = __builtin_bit_cast(unsigned, f); return (u + 0x7fffu + ((u >> 16) & 1u)) >> 16; }
__device__ __forceinline__ unsigned pk2(float lo, float hi) { return f2bf(lo) | (f2bf(hi) << 16); }
__device__ __forceinline__ float bf_lo(unsigned w) { return __builtin_bit_cast(float, w << 16); }
__device__ __forceinline__ float bf_hi(unsigned w) { return __builtin_bit_cast(float, w & 0xffff0000u); }
__device__ __forceinline__ float wave_sum(float v) {
#pragma unroll
    for (int o = 1; o < 64; o <<= 1) v += __shfl_xor(v, o);
    return v;
}
__device__ __forceinline__ float silu_f(float a) { return a * __builtin_amdgcn_rcpf(1.0f + __builtin_amdgcn_exp2f(-1.44269504089f * a)); }

namespace pg8 {
typedef unsigned u32x2 __attribute__((ext_vector_type(2)));
struct EpiPair {
    static constexpr bool PERM = true, AFTER_DRAIN = false;
    bf16_t* O1; int ld1; bf16_t* O2; int ld2; int npair; const float* ssq; const float* sw; int N; int mode;
    __device__ __forceinline__ void operator()(const f32x4 (&acc)[2][2][4][2], const Unit& u, int wr, int wc, int fr, int fq) const {
        const int b = u.pm >> 5, row0 = u.pm * BM + wr * 64 + fr, cw = wc * 32 + 8 * fq;
        const float* swp = sw + (size_t)b * N + u.pn * BM + cw;
        f32x4 bv[2][2];
#pragma unroll
        for (int bj = 0; bj < 2; ++bj)
#pragma unroll
            for (int n = 0; n < 2; ++n) bv[bj][n] = *(const f32x4*)(swp + bj * HALF + 4 * n);
        float rsv[8];
        { f32x4 pv8[8];
#pragma unroll
          for (int rg = 0; rg < 8; ++rg) pv8[rg] = *(const f32x4*)(ssq + (size_t)(row0 + (rg >> 2) * HALF + (rg & 3) * 16) * 16 + 4 * fq);
#pragma unroll
          for (int rg = 0; rg < 8; ++rg) { float t = (pv8[rg][0] + pv8[rg][1]) + (pv8[rg][2] + pv8[rg][3]); t += __shfl_xor(t, 16); t += __shfl_xor(t, 32); rsv[rg] = __builtin_amdgcn_rsqf(t * (1.0f / 1024.0f) + 1e-5f); } }
        if (u.pn < npair) {
            bf16_t* base = mode == 0 ? O1 + (size_t)u.pm * ((size_t)BM * ld1) + (size_t)(2 * u.pn + (wc >> 1)) * (BM * 64) + 32 * (wc & 1) + 8 * fq : O1 + u.pn * HALF + cw;
            const int rstr = mode == 0 ? 64 : ld1, rsub = mode == 0 ? u.pm * BM : 0;
#pragma unroll
            for (int ai = 0; ai < 2; ++ai)
#pragma unroll
                for (int m = 0; m < 4; ++m) { const int r = row0 + ai * HALF + m * 16; const float rs = rsv[ai * 4 + m];
                    const f32x4 a0 = acc[ai][0][m][0] * rs + bv[0][0], a1 = acc[ai][0][m][1] * rs + bv[0][1], b0 = acc[ai][1][m][0] * rs + bv[1][0], b1 = acc[ai][1][m][1] * rs + bv[1][1];
                    f32x4 v0, v1;
                    if (mode == 0) {
#pragma unroll
                        for (int j = 0; j < 4; ++j) { v0[j] = silu_f(a0[j]) * b0[j]; v1[j] = silu_f(a1[j]) * b1[j]; }
                    } else { v0 = a0 * b0; v1 = a1 * b1; }
                    u32x4 w; w.x = cvt_pk_bf16(v0[0], v0[1]); w.y = cvt_pk_bf16(v0[2], v0[3]); w.z = cvt_pk_bf16(v1[0], v1[1]); w.w = cvt_pk_bf16(v1[2], v1[3]);
                    *(u32x4*)(base + (size_t)(r - rsub) * rstr) = w; }
        } else {
            bf16_t* base = O2 + (u.pn - npair) * BM + cw;
#pragma unroll
            for (int ai = 0; ai < 2; ++ai)
#pragma unroll
                for (int m = 0; m < 4; ++m) { const int r = row0 + ai * HALF + m * 16; const float rs = rsv[ai * 4 + m];
#pragma unroll
                    for (int bj = 0; bj < 2; ++bj) { const f32x4 v0 = acc[ai][bj][m][0] * rs + bv[bj][0], v1 = acc[ai][bj][m][1] * rs + bv[bj][1];
                        u32x4 w; w.x = cvt_pk_bf16(v0[0], v0[1]); w.y = cvt_pk_bf16(v0[2], v0[3]); w.z = cvt_pk_bf16(v1[0], v1[1]); w.w = cvt_pk_bf16(v1[2], v1[3]);
                        *(u32x4*)(base + (size_t)r * ld2 + bj * HALF) = w; } }
        }
    }
};
struct EpiRope {
    static constexpr bool PERM = true, AFTER_DRAIN = false;
    bf16_t* O1; bf16_t* O2; int nrope; float scale1; const float* ssq; const float* sw; int N; const float* cs;
    __device__ __forceinline__ void operator()(const f32x4 (&acc)[2][2][4][2], const Unit& u, int wr, int wc, int fr, int fq) const {
        const int b = u.pm >> 5, row0 = u.pm * BM + wr * 64 + fr, cw = wc * 32 + 8 * fq;
        const float* swp = sw + (size_t)b * N + u.pn * BM + cw;
        f32x4 bv[2][2];
#pragma unroll
        for (int bj = 0; bj < 2; ++bj)
#pragma unroll
            for (int n = 0; n < 2; ++n) bv[bj][n] = *(const f32x4*)(swp + bj * HALF + 4 * n);
        const bool rope = u.pn < nrope;
        bf16_t* const obase = rope ? O1 : O2; const int pnl = rope ? u.pn : u.pn - nrope, shd = 2 * (pnl >> 1), dimc = 32 * (wc & 1) + 8 * fq;
        const float sc = rope ? scale1 : 1.0f;
        const bool rw = rope && ((wc & 1) == 0);
        const float sgn = (fq == 0) ? -1.0f : 1.0f;
        float rsv[8];
        { f32x4 pv8[8];
#pragma unroll
          for (int rg = 0; rg < 8; ++rg) pv8[rg] = *(const f32x4*)(ssq + (size_t)(row0 + (rg >> 2) * HALF + (rg & 3) * 16) * 16 + 4 * fq);
#pragma unroll
          for (int rg = 0; rg < 8; ++rg) { float t = (pv8[rg][0] + pv8[rg][1]) + (pv8[rg][2] + pv8[rg][3]); t += __shfl_xor(t, 16); t += __shfl_xor(t, 32); rsv[rg] = __builtin_amdgcn_rsqf(t * (1.0f / 1024.0f) + 1e-5f); } }
#pragma unroll
        for (int ai = 0; ai < 2; ++ai)
#pragma unroll
            for (int m = 0; m < 4; ++m) { const int r = row0 + ai * HALF + m * 16;
                f32x4 c0 = (f32x4){1.f, 1.f, 1.f, 1.f}, c1 = c0, s0 = (f32x4){0.f, 0.f, 0.f, 0.f}, s1 = s0;
                if (rw && fq < 2) { const float* cp = cs + (size_t)r * 16; c0 = *(const f32x4*)(cp); c1 = *(const f32x4*)(cp + 4); s0 = *(const f32x4*)(cp + 8) * sgn; s1 = *(const f32x4*)(cp + 12) * sgn; }
                const float rs = rsv[ai * 4 + m];
#pragma unroll
                for (int bj = 0; bj < 2; ++bj) { f32x4 v0 = acc[ai][bj][m][0] * rs + bv[bj][0], v1 = acc[ai][bj][m][1] * rs + bv[bj][1];
                    if (rw) { f32x4 p0, p1;
#pragma unroll
                        for (int j = 0; j < 4; ++j) { p0[j] = __shfl_xor(v0[j], 16); p1[j] = __shfl_xor(v1[j], 16); }
                        v0 = v0 * c0 + p0 * s0; v1 = v1 * c1 + p1 * s1; }
                    v0 = v0 * sc; v1 = v1 * sc;
                    u32x4 w; w.x = cvt_pk_bf16(v0[0], v0[1]); w.y = cvt_pk_bf16(v0[2], v0[3]); w.z = cvt_pk_bf16(v1[0], v1[1]); w.w = cvt_pk_bf16(v1[2], v1[3]);
                    { const int head = 4 * pnl + 2 * bj + (wc >> 1), tt = r & 8191, chain = ((((r >> 13) * 24 + head) << shd) + (tt & ((1 << shd) - 1)));
                      *(u32x4*)(obase + ((size_t)chain << (19 - shd)) + ((tt >> shd) << 6) + dimc) = w; } } }
    }
};
struct EpiRes {
    static constexpr bool PERM = true, AFTER_DRAIN = false;
    bf16_t* x; const float* gate; const float* gs1; bf16_t* xs1; const float* gs2; bf16_t* xs2; float* ssq;
    __device__ __forceinline__ void operator()(const f32x4 (&acc)[2][2][4][2], const Unit& u, int wr, int wc, int fr, int fq) const {
        const int b = u.pm >> 5, row0 = u.pm * BM + wr * 64 + fr, cw = u.pn * BM + wc * 64 + 8 * fq;
#pragma unroll
        for (int ai = 0; ai < 2; ++ai) { float ss4[4] = {0.f, 0.f, 0.f, 0.f};
#pragma unroll
        for (int bj = 0; bj < 2; ++bj) { const int colb = cw + bj * 32;
            const size_t boff = (size_t)u.pm * (256 * 1024) + (size_t)(4 * u.pn + wc) * (256 * 64) + (size_t)(wr * 64 + fr) * 64 + 32 * bj + 8 * fq;
            u32x4 xr[4];
#pragma unroll
            for (int m = 0; m < 4; ++m) xr[m] = *(const u32x4*)(x + boff + (size_t)(ai * HALF + m * 16) * 64);
            const f32x4 gta = *(const f32x4*)(gate + b * 1024 + colb), gtb = *(const f32x4*)(gate + b * 1024 + colb + 4);
            const f32x4 g1a = *(const f32x4*)(gs1 + b * 1024 + colb), g1b = *(const f32x4*)(gs1 + b * 1024 + colb + 4);
#pragma unroll
            for (int m = 0; m < 4; ++m) { const size_t off = boff + (size_t)(ai * HALF + m * 16) * 64;
                const u32x4 xc = xr[m];
                const f32x4 xo0 = (f32x4){__builtin_bit_cast(float, xc.x << 16), __builtin_bit_cast(float, xc.x & 0xffff0000u), __builtin_bit_cast(float, xc.y << 16), __builtin_bit_cast(float, xc.y & 0xffff0000u)};
                const f32x4 xo1 = (f32x4){__builtin_bit_cast(float, xc.z << 16), __builtin_bit_cast(float, xc.z & 0xffff0000u), __builtin_bit_cast(float, xc.w << 16), __builtin_bit_cast(float, xc.w & 0xffff0000u)};
                const f32x4 xn0 = xo0 + gta * acc[ai][bj][m][0], xn1 = xo1 + gtb * acc[ai][bj][m][1];
                { u32x4 w; w.x = cvt_pk_bf16(xn0[0], xn0[1]); w.y = cvt_pk_bf16(xn0[2], xn0[3]); w.z = cvt_pk_bf16(xn1[0], xn1[1]); w.w = cvt_pk_bf16(xn1[2], xn1[3]); *(u32x4*)(x + off) = w; }
                ss4[m] += ((xn0[0] * xn0[0] + xn0[1] * xn0[1]) + (xn0[2] * xn0[2] + xn0[3] * xn0[3])) + ((xn1[0] * xn1[0] + xn1[1] * xn1[1]) + (xn1[2] * xn1[2] + xn1[3] * xn1[3]));
                if (xs1) { const f32x4 y0 = xn0 * g1a, y1 = xn1 * g1b; u32x4 w; w.x = cvt_pk_bf16(y0[0], y0[1]); w.y = cvt_pk_bf16(y0[2], y0[3]); w.z = cvt_pk_bf16(y1[0], y1[1]); w.w = cvt_pk_bf16(y1[2], y1[3]); *(u32x4*)(xs1 + off) = w; }
                if (xs2) { const f32x4 y0 = xn0 * *(const f32x4*)(gs2 + b * 1024 + colb), y1 = xn1 * *(const f32x4*)(gs2 + b * 1024 + colb + 4); u32x4 w; w.x = cvt_pk_bf16(y0[0], y0[1]); w.y = cvt_pk_bf16(y0[2], y0[3]); w.z = cvt_pk_bf16(y1[0], y1[1]); w.w = cvt_pk_bf16(y1[2], y1[3]); *(u32x4*)(xs2 + off) = w; } }
            asm volatile("" ::: "memory"); }
#pragma unroll
            for (int m = 0; m < 4; ++m) { ss4[m] += __shfl_xor(ss4[m], 16); ss4[m] += __shfl_xor(ss4[m], 32); }
            const float mine = fq == 0 ? ss4[0] : fq == 1 ? ss4[1] : fq == 2 ? ss4[2] : ss4[3];
            ssq[(size_t)(row0 + ai * HALF + fq * 16) * 16 + u.pn * 4 + wc] = mine; }
    }
};
}

__device__ __forceinline__ int mapcol(int map, int n0) {
    if (map == 0) return n0;
    const int pn = n0 >> 8, jj = n0 & 255;
    if (map == 3) return 256 * pn + 64 * ((jj & 127) >> 5) + 32 * (jj >> 7) + (jj & 31);
    if (map == 1) return jj < 128 ? 128 * pn + jj : FF + 128 * pn + (jj - 128);
    if (pn < 8) return jj < 128 ? 1024 + 128 * pn + jj : 2048 + 128 * pn + (jj - 128);
    return 256 * (pn - 8) + jj;
}
__device__ __forceinline__ void transpose_item(const float* W, int K, int N, bf16* WT, int map, LAS float* scr, int item, int lane) {
    const int nblk = N / 64, kb = item / nblk, nb = item % nblk, k0 = 64 * kb, n0 = 64 * nb;
    const int t = lane & 31, sc = (t < 16 ? mapcol(map, n0) + 2 * t : mapcol(map, n0 + 32) + 2 * (t - 16));
    LAS unsigned char* sb = (LAS unsigned char*)scr;
    const float* wp = W + (size_t)(k0 + (lane >> 5)) * N + sc;
#pragma unroll 8
    for (int i = 0; i < 32; ++i) { const float2 v = *(const float2*)(wp + (size_t)(2 * i) * N); *(LAS unsigned*)(sb + (2 * i + (lane >> 5)) * 132 + 4 * t) = pk2(v.x, v.y); }
    asm volatile("s_waitcnt lgkmcnt(0)" ::: "memory");
    const int c = lane & 7, nn = lane >> 3;
#pragma unroll
    for (int j = 0; j < 8; ++j) { const int n = nn + 8 * j; const LAS unsigned char* sp = sb + (8 * c) * 132 + 2 * n;
        v4u o; o.x = (unsigned)*(const LAS unsigned short*)(sp) | ((unsigned)*(const LAS unsigned short*)(sp + 132) << 16); o.y = (unsigned)*(const LAS unsigned short*)(sp + 264) | ((unsigned)*(const LAS unsigned short*)(sp + 396) << 16);
        o.z = (unsigned)*(const LAS unsigned short*)(sp + 528) | ((unsigned)*(const LAS unsigned short*)(sp + 660) << 16); o.w = (unsigned)*(const LAS unsigned short*)(sp + 792) | ((unsigned)*(const LAS unsigned short*)(sp + 924) << 16);
        *(v4u*)(WT + (size_t)(n0 + n) * K + k0 + 8 * c) = o; }
    asm volatile("s_waitcnt lgkmcnt(0)" ::: "memory");
}
struct Params { const float* in[20]; float* out; unsigned char* ws; double inv[8]; int lo, hi; };

#define PIN(i) in_ptr(lds, i)
__device__ __forceinline__ const float* in_ptr(LAS unsigned char* lds, int i) { const unsigned long long v = ((const LAS unsigned long long*)(lds + 131072 + 1024))[i];
    const unsigned lo = __builtin_amdgcn_readfirstlane((unsigned)v), hi = __builtin_amdgcn_readfirstlane((unsigned)(v >> 32)); return (const float*)(const __attribute__((address_space(1))) float*)(((unsigned long long)hi << 32) | lo); }
__device__ __forceinline__ void convert_layer(LAS unsigned char* lds, int L, unsigned char* ws, LAS float* scr, int gw, int NGW, int lane) {
    constexpr int I_IN = 16 * (NFF2 / 64), I_OUT = (FF / 64) * 16, I_CIN = 16 * 48, I_COUT = 16 * 16, I_Q = 16 * 24, I_O = 8 * 16, I_KV = 16 * 48;
    const float* f1in = PIN(6) + (size_t)L * D * NFF2; const float* f1out = PIN(7) + (size_t)L * FF * D;
    const float* f2in = PIN(8) + (size_t)L * D * NFF2; const float* f2out = PIN(9) + (size_t)L * FF * D;
    const bool conv = L < 2; const int j = L - 2;
    const int i_mi = conv ? I_CIN : I_Q, i_mo = conv ? I_COUT : I_O, i_kv = (L == 2) ? I_KV : 0;
    const int total = 2 * I_IN + 2 * I_OUT + i_mi + i_mo + i_kv;
    for (int it = gw; it < total; it += NGW) {
        int r = it;
        if (r < I_IN) { transpose_item(f1in, D, NFF2, (bf16*)(ws + W_F1IN), 1, scr, r, lane); continue; } r -= I_IN;
        if (r < I_IN) { transpose_item(f2in, D, NFF2, (bf16*)(ws + W_F2IN), 1, scr, r, lane); continue; } r -= I_IN;
        if (r < I_OUT) { transpose_item(f1out, FF, D, (bf16*)(ws + W_F1OUT), 3, scr, r, lane); continue; } r -= I_OUT;
        if (r < I_OUT) { transpose_item(f2out, FF, D, (bf16*)(ws + W_F2OUT), 3, scr, r, lane); continue; } r -= I_OUT;
        if (r < i_mi) { if (conv) transpose_item(PIN(10) + (size_t)L * D * 3072, D, 3072, (bf16*)(ws + W_MXIN), 2, scr, r, lane);
                        else transpose_item(PIN(17) + (size_t)j * D * QW, D, QW, (bf16*)(ws + W_MXIN), 0, scr, r, lane); continue; } r -= i_mi;
        if (r < i_mo) { if (conv) transpose_item(PIN(12) + (size_t)L * D * D, D, D, (bf16*)(ws + W_MXOUT), 3, scr, r, lane);
                        else transpose_item(PIN(18) + (size_t)j * OW * D, OW, D, (bf16*)(ws + W_MXOUT), 3, scr, r, lane); continue; } r -= i_mo;
        transpose_item(PIN(16), D, 3072, (bf16*)(ws + W_KV), 0, scr, r, lane);
    }
}
__device__ __forceinline__ void swp_matrix(const bf16* Wt, int N, const float* sh, float* out, int gw, int NGW, int lane) {
    f32x4 s[4][4];
#pragma unroll
    for (int b = 0; b < 4; ++b)
#pragma unroll
        for (int j = 0; j < 2; ++j) { s[b][2 * j] = *(const f32x4*)(sh + b * 1024 + 512 * j + 8 * lane); s[b][2 * j + 1] = *(const f32x4*)(sh + b * 1024 + 512 * j + 8 * lane + 4); }
    for (int n = gw; n < N; n += NGW) {
        const v4u w0 = *(const v4u*)(Wt + (size_t)n * 1024 + 8 * lane), w1 = *(const v4u*)(Wt + (size_t)n * 1024 + 512 + 8 * lane);
        f32x4 x[4]; x[0] = (f32x4){bf_lo(w0.x), bf_hi(w0.x), bf_lo(w0.y), bf_hi(w0.y)}; x[1] = (f32x4){bf_lo(w0.z), bf_hi(w0.z), bf_lo(w0.w), bf_hi(w0.w)};
        x[2] = (f32x4){bf_lo(w1.x), bf_hi(w1.x), bf_lo(w1.y), bf_hi(w1.y)}; x[3] = (f32x4){bf_lo(w1.z), bf_hi(w1.z), bf_lo(w1.w), bf_hi(w1.w)};
        float a[4];
#pragma unroll
        for (int b = 0; b < 4; ++b) { f32x4 t = x[0] * s[b][0] + x[1] * s[b][1] + x[2] * s[b][2] + x[3] * s[b][3]; a[b] = wave_sum((t[0] + t[1]) + (t[2] + t[3])); }
        if (lane < 4) out[(size_t)lane * N + n] = lane == 0 ? a[0] : lane == 1 ? a[1] : lane == 2 ? a[2] : a[3];
    }
}
__device__ __forceinline__ void swp_layer(int L, unsigned char* wst, unsigned char* ws, int gw, int NGW, int lane) {
    const float* SH = (const float*)(wst + WS_TAB) + 13 * 4096; float* SW = (float*)(wst + WS_SW) + (L & 1) * SW_SZ;
    swp_matrix((const bf16*)(ws + W_F1IN), NFF2, SH + (3 * L + 0) * 4096, SW + SW_F1, gw, NGW, lane);
    swp_matrix((const bf16*)(ws + W_MXIN), L < 2 ? 3072 : QW, SH + (3 * L + 1) * 4096, SW + SW_MX, gw, NGW, lane);
    swp_matrix((const bf16*)(ws + W_F2IN), NFF2, SH + (3 * L + 2) * 4096, SW + SW_F2, gw, NGW, lane);
    if (L == 2) swp_matrix((const bf16*)(ws + W_KV), 3072, SH + 12 * 4096, SW + SW_KV, gw, NGW, lane);
}

constexpr int AT_KP = 144, AT_VP = 528, AT_VOFF = 256 * AT_KP;
struct AtUnit { int ib, d, r, g, h, rowb, hoff, cb; };
__device__ __forceinline__ AtUnit at_decode(int u) { AtUnit a; const int qb = u & 63, gb = u >> 9; a.h = (u >> 6) & 7; a.g = gb % 3; const int b = gb / 3, sh = 2 * a.g, nbk = 64 >> sh; a.d = 1 << sh; a.r = qb >> (6 - sh); a.ib = qb & (nbk - 1);
    a.hoff = (a.g * 8 + a.h) * 64; a.rowb = b * SEQ; a.cb = ((((b * 24 + a.g * 8 + a.h) << sh) + a.r) << (19 - sh)); return a; }
__device__ __forceinline__ void attn_phase(LAS unsigned char* lds, const bf16* Qb, const bf16* Kb, const bf16* Vb, bf16* og0, bf16* og1, bf16* og2, float* lse, int G, int wg, const int tid) {
    const int lane = tid & 63, w = __builtin_amdgcn_readfirstlane(tid >> 6), fr = lane & 15, kq = lane >> 4;
    constexpr int NU = NB * 3 * 8 * 64;
    const int per = (NU + G - 1) / G, u0 = wg * per, u1 = (u0 + per < NU) ? u0 + per : NU;
    if (u0 >= u1) return;
    const v4u z4 = (v4u){0u, 0u, 0u, 0u};
    const int kk0 = tid >> 3, kc = tid & 7, vjp = tid & 63, vc = tid >> 6;
    const int vkey = 2 * vjp, vpos = (vkey & ~31) + (((vkey >> 2) & 3) << 3) + (((vkey >> 4) & 1) << 2) + (vkey & 3);
    v4u rk0, rk1, rv0, rv1; bf16x8 rq0, rq1;
#define AT_LOAD_BLOCK(A, blk, K0, K1, V0, V1) do { const int t0_ = (A).cb + (blk) * 8192; \
        K0 = *(const v4u*)(Kb + (t0_ + kk0 * 64 + 8 * kc)); K1 = *(const v4u*)(Kb + (t0_ + (kk0 + 64) * 64 + 8 * kc)); \
        const bf16* vp_ = Vb + (t0_ + vkey * 64 + 8 * vc); V0 = *(const v4u*)vp_; V1 = *(const v4u*)(vp_ + 64); } while (0)
#define AT_STORE_BLOCK(slot, K0, K1, V0, V1) do { \
        *(LAS v4u*)(lds + ((slot) * 128 + kk0) * AT_KP + 16 * kc) = K0; *(LAS v4u*)(lds + ((slot) * 128 + kk0 + 64) * AT_KP + 16 * kc) = K1; \
        LAS unsigned char* vb_ = lds + AT_VOFF + (32 * (vc & 1) + 4 * (vc >> 1)) * AT_VP + ((slot) * 128 + vpos) * 2;     \
        *(LAS unsigned*)(vb_ + 0 * AT_VP) = (V0.x & 0xffffu) | (V1.x << 16); *(LAS unsigned*)(vb_ + 1 * AT_VP) = (V0.x >> 16) | (V1.x & 0xffff0000u); \
        *(LAS unsigned*)(vb_ + 2 * AT_VP) = (V0.y & 0xffffu) | (V1.y << 16); *(LAS unsigned*)(vb_ + 3 * AT_VP) = (V0.y >> 16) | (V1.y & 0xffff0000u); \
        *(LAS unsigned*)(vb_ + 16 * AT_VP) = (V0.z & 0xffffu) | (V1.z << 16); *(LAS unsigned*)(vb_ + 17 * AT_VP) = (V0.z >> 16) | (V1.z & 0xffff0000u); \
        *(LAS unsigned*)(vb_ + 18 * AT_VP) = (V0.w & 0xffffu) | (V1.w << 16); *(LAS unsigned*)(vb_ + 19 * AT_VP) = (V0.w >> 16) | (V1.w & 0xffff0000u); } while (0)
#define AT_LOAD_Q(A, Q0, Q1) do { const bf16* qp_ = Qb + ((A).cb + ((A).ib * 128 + 16 * w + fr) * 64 + 8 * kq); Q0 = *(const bf16x8*)qp_; Q1 = *(const bf16x8*)(qp_ + 32); } while (0)
    AtUnit cu = at_decode(u0);
    int ps = 0;
    __syncthreads();
    { v4u a0 = z4, a1 = z4, b0 = z4, b1 = z4; if (cu.ib > 0) AT_LOAD_BLOCK(cu, cu.ib - 1, a0, a1, b0, b1); AT_STORE_BLOCK(ps, a0, a1, b0, b1); }
    AT_LOAD_BLOCK(cu, cu.ib, rk0, rk1, rv0, rv1); AT_LOAD_Q(cu, rq0, rq1);
    for (int u = u0; u < u1; ++u) {
        const int cs = ps ^ 1;
        if (u > u0 && cu.ib == 0) AT_STORE_BLOCK(ps, z4, z4, z4, z4);
        AT_STORE_BLOCK(cs, rk0, rk1, rv0, rv1);
        const bf16x8 qf0 = rq0, qf1 = rq1;
        const AtUnit au = cu;
        __syncthreads();
        if (u + 1 < u1) { cu = at_decode(u + 1); AT_LOAD_BLOCK(cu, cu.ib, rk0, rk1, rv0, rv1); AT_LOAD_Q(cu, rq0, rq1); }
        const int qi = 16 * w + fr;
        const int qrow = au.rowb + (au.ib * 128 + qi) * au.d + au.r;
        int wv = w, psv = ps; asm volatile("" : "+v"(wv), "+v"(psv));
        const int G0 = 2 * (wv >> 1);
        f32x4 sc[10];
        {
            const LAS unsigned char* kb0 = lds + fr * AT_KP + 16 * kq;
#pragma unroll
            for (int hh = 0; hh < 2; ++hh) { bf16x8 kf[5][2];
#pragma unroll
                for (int g5 = 0; g5 < 5; ++g5) { const int Gp = (G0 + hh * 5 + g5) ^ (psv << 3); const LAS unsigned char* kp = kb0 + Gp * (16 * AT_KP); kf[g5][0] = *(const LAS bf16x8*)kp; kf[g5][1] = *(const LAS bf16x8*)(kp + 64); }
#pragma unroll
                for (int g5 = 0; g5 < 5; ++g5) { f32x4 a = (f32x4){0.f, 0.f, 0.f, 0.f};
                    a = __builtin_amdgcn_mfma_f32_16x16x32_bf16(kf[g5][0], qf0, a, 0, 0, 0); a = __builtin_amdgcn_mfma_f32_16x16x32_bf16(kf[g5][1], qf1, a, 0, 0, 0); sc[hh * 5 + g5] = a; } }
        }
        const int dl0 = 4 * kq - fr;
#define AT_MASK(ODD) do { _Pragma("unroll") for (int i = 0; i < 4; ++i) { if (dl0 + i < 0) sc[ODD][i] = -INFINITY; if (dl0 + i > 0) sc[8 + ODD][i] = -INFINITY; sc[(ODD) ? 0 : 9][i] = -INFINITY; } } while (0)
        if (w & 1) AT_MASK(1); else AT_MASK(0);
#undef AT_MASK
        if (au.ib == 0) {
#pragma unroll
            for (int gg = 0; gg < 8; ++gg) if (G0 + gg < 8) sc[gg] = (f32x4){-INFINITY, -INFINITY, -INFINITY, -INFINITY};
        }
        float mx = -INFINITY;
#pragma unroll
        for (int gg = 0; gg < 10; ++gg) mx = fmaxf(fmaxf(mx, fmaxf(sc[gg][0], sc[gg][1])), fmaxf(sc[gg][2], sc[gg][3]));
        mx = fmaxf(mx, __shfl_xor(mx, 16)); mx = fmaxf(mx, __shfl_xor(mx, 32));
        float den = 0.f;
#pragma unroll
        for (int gg = 0; gg < 10; ++gg)
#pragma unroll
            for (int i = 0; i < 4; ++i) { const float pv = __builtin_amdgcn_exp2f(sc[gg][i] - mx); sc[gg][i] = pv; den += pv; }
        den += __shfl_xor(den, 16); den += __shfl_xor(den, 32);
        f32x4 o[4];
#pragma unroll
        for (int nt = 0; nt < 4; ++nt) o[nt] = (f32x4){0.f, 0.f, 0.f, 0.f};
        {   const LAS unsigned char* vb0 = lds + AT_VOFF + fr * AT_VP + 16 * kq;
            bf16x8 vf[2][4];
#define AT_VLOAD(cc, buf) do { const int chp_ = ((wv >> 1) + (cc)) ^ (psv << 2); const LAS unsigned char* vp_ = vb0 + chp_ * 64; _Pragma("unroll") for (int nt = 0; nt < 4; ++nt) vf[buf][nt] = *(const LAS bf16x8*)(vp_ + nt * (16 * AT_VP)); } while (0)
            AT_VLOAD(0, 0);
#pragma unroll
            for (int cc = 0; cc < 5; ++cc) {
                if (cc < 4) AT_VLOAD(cc + 1, (cc + 1) & 1);
                v4u pw; pw.x = cvt_pk_bf16(sc[2 * cc][0], sc[2 * cc][1]); pw.y = cvt_pk_bf16(sc[2 * cc][2], sc[2 * cc][3]); pw.z = cvt_pk_bf16(sc[2 * cc + 1][0], sc[2 * cc + 1][1]); pw.w = cvt_pk_bf16(sc[2 * cc + 1][2], sc[2 * cc + 1][3]);
                const bf16x8 pb = __builtin_bit_cast(bf16x8, pw);
#pragma unroll
                for (int nt = 0; nt < 4; ++nt) o[nt] = __builtin_amdgcn_mfma_f32_16x16x32_bf16(vf[cc & 1][nt], pb, o[nt], 0, 0, 0); }
#undef AT_VLOAD
        }
        const float inv = 1.0f / den;
        bf16* og = (au.g == 0) ? og0 : (au.g == 1) ? og1 : og2;
        bf16* op = og + (qrow * OW + au.h * 64 + 16 * kq);
#pragma unroll
        for (int hh = 0; hh < 2; ++hh) { v4u wv; wv.x = cvt_pk_bf16(o[2 * hh][0] * inv, o[2 * hh][1] * inv); wv.y = cvt_pk_bf16(o[2 * hh][2] * inv, o[2 * hh][3] * inv);
            wv.z = cvt_pk_bf16(o[2 * hh + 1][0] * inv, o[2 * hh + 1][1] * inv); wv.w = cvt_pk_bf16(o[2 * hh + 1][2] * inv, o[2 * hh + 1][3] * inv); *(v4u*)(op + 8 * hh) = wv; }
        if (kq == 0) lse[(au.cb >> 6) + au.ib * 128 + qi] = (mx + __builtin_amdgcn_logf(den)) * 0.69314718056f;
        ps = cs;
        __syncthreads();
    }
#undef AT_LOAD_BLOCK
#undef AT_STORE_BLOCK
#undef AT_LOAD_Q
}

#define XB_TMO      128
#define XB_XCNT(j)  (256  + 64 * (j))
#define XB_XSUB(j)  (1280 + 64 * (j))
#define XB_XGEN(j)  (2304 + 64 * (j))
#define XB_TOP      3328
#define XB_TOPGEN   3392
#define XCD_BAR_WORDS 3456
#define XB_SPIN_CAP (1u << 18)

__device__ __forceinline__ unsigned xb_ld(unsigned* p)              { return __hip_atomic_load(p, __ATOMIC_RELAXED, __HIP_MEMORY_SCOPE_AGENT); }
__device__ __forceinline__ unsigned xb_add(unsigned* p, unsigned v) { return __hip_atomic_fetch_add(p, v, __ATOMIC_RELAXED, __HIP_MEMORY_SCOPE_AGENT); }
__device__ __forceinline__ unsigned xb_xcc_id() { return (unsigned)__builtin_amdgcn_s_getreg((3 << 11) | 20) & 0xFu; }
#define XB_SPIN(cond, bar) do { unsigned _sp = 0; while (cond) { __builtin_amdgcn_s_sleep(1); \
    if ((++_sp & 255u) == 0u) { if (xb_ld(&(bar)[XB_TMO])) break; if (_sp > XB_SPIN_CAP) { atomicAdd(&(bar)[XB_TMO], 1u); break; } } } } while (0)

struct XcdBarrier {
    unsigned* bar; unsigned x;
    volatile LAS unsigned* st;
};

__device__ __forceinline__ XcdBarrier xcd_barrier_post(unsigned* bar, volatile LAS unsigned* st) {
    XcdBarrier b; b.bar = bar; b.x = xb_xcc_id(); b.st = st;
    if (threadIdx.x == 0) (void)xb_add(&bar[XB_XCNT(b.x)], 1u);
    return b;
}
__device__ __forceinline__ void xcd_barrier_complete(unsigned* bar, unsigned x, unsigned& nloc, unsigned& nx) {
    const unsigned G = gridDim.x * gridDim.y * gridDim.z;
    unsigned sum, cnt, mine, sp = 0u;
    for (;;) {
        sum = 0u; cnt = 0u; mine = 0u;
#pragma unroll
        for (unsigned j = 0; j < 16; ++j) { const unsigned c = xb_ld(&bar[XB_XCNT(j)]); sum += c; cnt += (c > 0u) ? 1u : 0u; mine = (j == x) ? c : mine; }
        if (sum == G) break;
        __builtin_amdgcn_s_sleep(1);
        if ((++sp & 255u) == 0u) { if (xb_ld(&bar[XB_TMO])) break; if (sp > XB_SPIN_CAP) { atomicAdd(&bar[XB_TMO], 1u); break; } }
    }
    nloc = mine > 0u ? mine : 1u; nx = cnt > 0u ? cnt : 1u;
}

__device__ __forceinline__ void xcd_barrier(const XcdBarrier& b) {
    asm volatile("s_waitcnt vmcnt(0)" ::: "memory");
    __syncthreads();
    if (threadIdx.x == 0) {
        unsigned* bar = b.bar;
        __builtin_amdgcn_s_waitcnt(0);
        unsigned nloc = b.st[0], nx = b.st[1];
        if (nloc == 0u) { xcd_barrier_complete(bar, b.x, nloc, nx); b.st[0] = nloc; b.st[1] = nx; }
        const unsigned old = xb_add(&bar[XB_XSUB(b.x)], 1u);
        const unsigned gen = old / nloc;
        if (old + 1u == (gen + 1u) * nloc) {
            __builtin_amdgcn_fence(__ATOMIC_RELEASE, "agent");
            asm volatile("s_waitcnt vmcnt(0)" ::: "memory");
            const unsigned og = xb_add(&bar[XB_TOP], 1u);
            const unsigned tg = og / nx;
            if (og + 1u == (tg + 1u) * nx) xb_add(&bar[XB_TOPGEN], 1u);
            else XB_SPIN(xb_ld(&bar[XB_TOPGEN]) == tg, bar);
            __builtin_amdgcn_fence(__ATOMIC_ACQUIRE, "agent");
            xb_add(&bar[XB_XGEN(b.x)], 1u);
            asm volatile("s_waitcnt vmcnt(0)" ::: "memory");
        } else {
            XB_SPIN(xb_ld(&bar[XB_XGEN(b.x)]) == gen, bar);
            __builtin_amdgcn_fence(__ATOMIC_ACQUIRE, "agent");
            asm volatile("s_waitcnt vmcnt(0)" ::: "memory");
        }
    }
    __syncthreads();
}

__global__ void __launch_bounds__(512, 2) fwd_megakernel(Params p) {
    extern __shared__ __attribute__((aligned(16))) unsigned char smem[];
    cg::grid_group grid = cg::this_grid();
    LAS unsigned char* lds = (LAS unsigned char*)smem;
    {
        LAS unsigned long long* PT0 = (LAS unsigned long long*)(lds + 131072 + 1024);
        if (threadIdx.x == 0) {
#pragma unroll
            for (int i = 0; i < 20; ++i) PT0[i] = (unsigned long long)p.in[i];
#pragma unroll
            for (int i = 0; i < 8; ++i) PT0[20 + i] = __builtin_bit_cast(unsigned long long, p.inv[i]);
        }
        if (threadIdx.x < 2) ((LAS unsigned*)(lds + 131072 + 2048))[threadIdx.x] = 0u;
        __syncthreads();
    }
    (void)xcd_barrier_post((unsigned*)(p.ws + WS_CTL), (volatile LAS unsigned*)(lds + 131072 + 2048));
    for (int ph = p.lo; ph < p.hi; ++ph) {
        int tid = threadIdx.x; asm volatile("" : "+v"(tid));
        int bx = blockIdx.x; asm volatile("" : "+s"(bx));
        int G = gridDim.x; asm volatile("" : "+s"(G));
        unsigned long long ws_raw = (unsigned long long)p.ws; asm volatile("" : "+s"(ws_raw));
        unsigned char* ws = (unsigned char*)(__attribute__((address_space(1))) unsigned char*)ws_raw;
        const int lane = tid & 63, wave = __builtin_amdgcn_readfirstlane(tid >> 6);
        const int gw = bx * 8 + wave, NGW = G * 8, gt = bx * 512 + tid, NGT = G * 512;
        float* SUMSQ = (float*)(ws + WS_SUMSQ); float* CS = (float*)(ws + WS_CS); float* MODP = (float*)(ws + WS_MODP);
        float* GS = (float*)(ws + WS_TAB); float* SH = GS + 13 * 4096; float* GATE = SH + 13 * 4096;
        bf16* XS = (bf16*)(ws + WS_XS); bf16* HB = (bf16*)(ws + WS_H); bf16* X16 = (bf16*)(ws + WS_X16); unsigned char* OB = (unsigned char*)(__attribute__((address_space(1))) unsigned char*)(unsigned long long)p.out;
        LAS float* scr = (LAS float*)(lds + wave * 16384);
        const int op = SCHED[ph], type = op & 15, L = (op >> 4) & 3, sb = op >> 6;
        unsigned char* const wsw = (L & 1) ? OB + (WB1_OFF - WS_W) : ws;
        unsigned char* const wsn = (L & 1) ? ws : OB + (WB1_OFF - WS_W);
        float* const SW = (float*)(ws + WS_SW) + (L & 1) * SW_SZ;
        switch (type) {
        case PH_P0A: {
            LAS float* cond = (LAS float*)lds;
            for (int i = tid; i < 4096; i += 512) { const int b = i >> 10, k = i & 1023; const float cv = PIN(1)[i]; cond[k * 4 + b] = cv / (1.0f + __expf(-cv)); }
            __syncthreads();
            for (int it = gw; it < 608 * 8; it += NGW) { const int cgp = it >> 3, ks = it & 7; const float* W; int ldw;
                if (cgp < 576) { const int Lm = cgp / 144; W = PIN(4) + (size_t)Lm * D * 9216 + (cgp % 144) * 64 + lane; ldw = 9216; } else { W = PIN(14) + (cgp - 576) * 64 + lane; ldw = 2048; }
                W += (size_t)(ks * 128) * ldw; float a0 = 0.f, a1 = 0.f, a2 = 0.f, a3 = 0.f;
#pragma unroll 16
                for (int k = 0; k < 128; ++k) { const float wv = W[(size_t)k * ldw]; const f32x4 cv = *(const LAS f32x4*)(cond + (ks * 128 + k) * 4); a0 += wv * cv[0]; a1 += wv * cv[1]; a2 += wv * cv[2]; a3 += wv * cv[3]; }
                float* mp = MODP + (size_t)(ks * 4) * NMODCOL + cgp * 64 + lane; mp[0] = a0; mp[NMODCOL] = a1; mp[2 * NMODCOL] = a2; mp[3 * NMODCOL] = a3; }
            __syncthreads();
            convert_layer(lds, 0, wsw, scr, gw, NGW, lane);
            for (int i = gt; i < T * 8; i += NGT) { const int row = i >> 3, j = i & 7; const double rev = (double)((const int*)PIN(2))[row] * __builtin_bit_cast(double, ((const LAS unsigned long long*)(lds + 131072 + 1024))[20 + j]);
                const float frv = (float)(rev - __builtin_floor(rev)); CS[row * 16 + j] = __builtin_amdgcn_cosf(frv); CS[row * 16 + 8 + j] = __builtin_amdgcn_sinf(frv); }
        } break;
        case PH_P0B: {
            for (int i = gt; i < 13 * 4096; i += NGT) { const int s = i >> 12, b = (i >> 10) & 3, c = i & 1023;
                if (s < 12) { const int Lm = s / 3, sbm = s % 3; float m3[3];
#pragma unroll
                    for (int q = 0; q < 3; ++q) { const int idx = (3 * sbm + q) * 1024 + c; float a = PIN(5)[Lm * 9216 + idx];
#pragma unroll
                        for (int ks = 0; ks < 8; ++ks) a += MODP[(size_t)(ks * 4 + b) * NMODCOL + Lm * 9216 + idx]; m3[q] = a; }
                    SH[i] = m3[0]; GS[i] = PIN(3)[(Lm * 3 + sbm) * 1024 + c] * (1.0f + m3[1]); GATE[i] = (sbm == 1 ? 1.0f : 0.5f) * (1.0f + m3[2]);
                } else { float m2[2];
#pragma unroll
                    for (int q = 0; q < 2; ++q) { const int idx = q * 1024 + c; float a = PIN(15)[idx];
#pragma unroll
                        for (int ks = 0; ks < 8; ++ks) a += MODP[(size_t)(ks * 4 + b) * NMODCOL + 36864 + idx]; m2[q] = a; }
                    SH[i] = m2[0]; GS[i] = PIN(13)[c] * (1.0f + m2[1]); } }
        } break;
        case PH_P0C: {
            swp_layer(0, ws, wsw, gw, NGW, lane);
            for (int m = gw; m < T; m += NGW) { const f32x4* xr = (const f32x4*)(PIN(0) + (size_t)m * D) + lane; const f32x4* gr = (const f32x4*)(GS + (m >> 13) * 1024) + lane;
                f32x4 v[4]; float s = 0.f;
#pragma unroll
                for (int j = 0; j < 4; ++j) { v[j] = xr[64 * j]; s += (v[j][0] * v[j][0] + v[j][1] * v[j][1]) + (v[j][2] * v[j][2] + v[j][3] * v[j][3]); }
                s = wave_sum(s); if (lane < 16) SUMSQ[(size_t)m * 16 + lane] = lane == 0 ? s : 0.f;
                const size_t bo = blk_off(m, 4 * lane);
#pragma unroll
                for (int j = 0; j < 4; ++j) { const f32x4 y = v[j] * gr[64 * j]; v2u wv; wv.x = pk2(y[0], y[1]); wv.y = pk2(y[2], y[3]); *(v2u*)(XS + bo + (size_t)j * (4 * 256 * 64)) = wv; v2u xv; xv.x = pk2(v[j][0], v[j][1]); xv.y = pk2(v[j][2], v[j][3]); *(v2u*)(X16 + bo + (size_t)j * (4 * 256 * 64)) = xv; } }
        } break;
        case PH_PW: convert_layer(lds, L, wsw, scr, gw, NGW, lane); break;
        case PH_SWP: swp_layer(L, ws, wsw, gw, NGW, lane); break;
        case PH_PAIR: {
            const int s = 3 * L + sb; const bool ffn = sb != 1;
            pg8::Gemm g{XS, (const bf16*)(wsw + (sb == 0 ? W_F1IN : sb == 1 ? W_MXIN : W_F2IN)), T, ffn ? NFF2 : 3072, D, 1};
            pg8::StaticOrder S; S.init(g.M, g.N, G, bx);
            pg8::EpiPair E{ffn ? HB : (bf16*)(ws + WS_V1), ffn ? FF : D, (bf16*)(ws + WS_BG), D, ffn ? 22 : 8, SUMSQ, SW + (sb == 0 ? SW_F1 : sb == 1 ? SW_MX : SW_F2), g.N, ffn ? 0 : 1};
            pg8::gemm_phase<pg8::EpiPair, pg8::StaticOrder, true, true>(lds, g, S, E, tid);
        } break;
        case PH_RES: {
            const int s = 3 * L + sb; const bool ffn = sb != 1;
            pg8::Gemm g{ffn ? HB : (L < 2 ? (const bf16*)OB : (const bf16*)(ws + WS_MIX)), (const bf16*)(wsw + (sb == 0 ? W_F1OUT : sb == 1 ? W_MXOUT : W_F2OUT)), T, D, ffn ? FF : (L < 2 ? D : OW), ffn ? 1 : 0};
            pg8::StaticOrder S; S.init(g.M, g.N, G, bx);
            pg8::EpiRes E{X16, GATE + s * 4096, GS + (s < 11 ? s + 1 : 0) * 4096, s < 11 ? XS : nullptr, GS + 12 * 4096, s == 5 ? (bf16*)OB : nullptr, SUMSQ};
            pg8::gemm_phase<pg8::EpiRes, pg8::StaticOrder, true, true>(lds, g, S, E, tid);
            if (sb == 1 && L < 3) swp_layer(L + 1, ws, wsn, gw, NGW, lane);
        } break;
        case PH_ROPE: {
            const bool kv = sb == 1;
            pg8::Gemm g{kv ? (const bf16*)OB : XS, (const bf16*)(wsw + (kv ? W_KV : W_MXIN)), T, kv ? 3072 : QW, D, 1};
            pg8::StaticOrder S; S.init(g.M, g.N, G, bx);
            pg8::EpiRope E{kv ? (bf16*)(ws + WS_K) : (bf16*)(ws + WS_Q), (bf16*)(ws + WS_V), 6, kv ? 1.0f : 0.125f * 1.44269504089f, SUMSQ, SW + (kv ? SW_KV : SW_MX), g.N, CS};
            pg8::gemm_phase<pg8::EpiRope, pg8::StaticOrder, true, true>(lds, g, S, E, tid);
        } break;
        case PH_CONVEW: {
            const bf16* V1 = (const bf16*)(ws + WS_V1); const bf16* BG = (const bf16*)(ws + WS_BG); bf16* Y = (bf16*)OB; const float* cw = PIN(11) + L * 3 * D;
            for (int i = gt; i < T * 128; i += NGT) { const int row = i >> 7, c8 = (i & 127) * 8, sq = row & (SEQ - 1); const size_t off = (size_t)row * D + c8;
                const v4u z = (v4u){0u, 0u, 0u, 0u};
                const v4u v2 = *(const v4u*)(V1 + off), v1 = sq >= 1 ? *(const v4u*)(V1 + off - D) : z, v0 = sq >= 2 ? *(const v4u*)(V1 + off - 2 * D) : z, bg = *(const v4u*)(BG + off);
                const f32x4 w0a = *(const f32x4*)(cw + c8), w0b = *(const f32x4*)(cw + c8 + 4), w1a = *(const f32x4*)(cw + D + c8), w1b = *(const f32x4*)(cw + D + c8 + 4), w2a = *(const f32x4*)(cw + 2 * D + c8), w2b = *(const f32x4*)(cw + 2 * D + c8 + 4);
                v4u o;
                o.x = pk2(bf_lo(bg.x) * (w0a[0] * bf_lo(v0.x) + w1a[0] * bf_lo(v1.x) + w2a[0] * bf_lo(v2.x)), bf_hi(bg.x) * (w0a[1] * bf_hi(v0.x) + w1a[1] * bf_hi(v1.x) + w2a[1] * bf_hi(v2.x)));
                o.y = pk2(bf_lo(bg.y) * (w0a[2] * bf_lo(v0.y) + w1a[2] * bf_lo(v1.y) + w2a[2] * bf_lo(v2.y)), bf_hi(bg.y) * (w0a[3] * bf_hi(v0.y) + w1a[3] * bf_hi(v1.y) + w2a[3] * bf_hi(v2.y)));
                o.z = pk2(bf_lo(bg.z) * (w0b[0] * bf_lo(v0.z) + w1b[0] * bf_lo(v1.z) + w2b[0] * bf_lo(v2.z)), bf_hi(bg.z) * (w0b[1] * bf_hi(v0.z) + w1b[1] * bf_hi(v1.z) + w2b[1] * bf_hi(v2.z)));
                o.w = pk2(bf_lo(bg.w) * (w0b[2] * bf_lo(v0.w) + w1b[2] * bf_lo(v1.w) + w2b[2] * bf_lo(v2.w)), bf_hi(bg.w) * (w0b[3] * bf_hi(v0.w) + w1b[3] * bf_hi(v1.w) + w2b[3] * bf_hi(v2.w)));
                *(v4u*)(Y + off) = o; }
            __syncthreads(); convert_layer(lds, L + 1, wsn, scr, gw, NGW, lane);
        } break;
        case PH_ATTN:
            attn_phase(lds, (const bf16*)(ws + WS_Q), (const bf16*)(ws + WS_K), (const bf16*)(ws + WS_V), (bf16*)OB, (bf16*)(OB + 32 * MiB), (bf16*)(ws + WS_OG2), (float*)(ws + WS_LSE), G, bx, tid);
            if (L == 2) { __syncthreads(); convert_layer(lds, 3, wsn, scr, gw, NGW, lane); }
            break;
        case PH_MERGE: {
            const bf16* o0 = (const bf16*)OB; const bf16* o1 = (const bf16*)(OB + 32 * MiB); const bf16* o2 = (const bf16*)(ws + WS_OG2); const float* lse = (const float*)(ws + WS_LSE); bf16* MIX = (bf16*)(ws + WS_MIX);
            for (int i = gt; i < T * 64; i += NGT) { const int row = i >> 6, c8 = (i & 63) * 8, h = c8 >> 6; const size_t off = (size_t)row * OW + c8;
                const int tt = row & 8191, bh = (row >> 13) * 24 + h;
                const float l0 = lse[(size_t)bh * 8192 + tt], l1 = lse[(size_t)((((bh + 8) << 2) + (tt & 3)) * 2048) + (tt >> 2)], l2 = lse[(size_t)((((bh + 16) << 4) + (tt & 15)) * 512) + (tt >> 4)];
                const float ml = fmaxf(l0, fmaxf(l1, l2)); float e0 = __expf(l0 - ml), e1 = __expf(l1 - ml), e2 = __expf(l2 - ml); const float is = 1.0f / (e0 + e1 + e2); e0 *= is; e1 *= is; e2 *= is;
                const v4u a = *(const v4u*)(o0 + off), bq = *(const v4u*)(o1 + off), cq = *(const v4u*)(o2 + off); v4u o;
                o.x = pk2(e0 * bf_lo(a.x) + e1 * bf_lo(bq.x) + e2 * bf_lo(cq.x), e0 * bf_hi(a.x) + e1 * bf_hi(bq.x) + e2 * bf_hi(cq.x));
                o.y = pk2(e0 * bf_lo(a.y) + e1 * bf_lo(bq.y) + e2 * bf_lo(cq.y), e0 * bf_hi(a.y) + e1 * bf_hi(bq.y) + e2 * bf_hi(cq.y));
                o.z = pk2(e0 * bf_lo(a.z) + e1 * bf_lo(bq.z) + e2 * bf_lo(cq.z), e0 * bf_hi(a.z) + e1 * bf_hi(bq.z) + e2 * bf_hi(cq.z));
                o.w = pk2(e0 * bf_lo(a.w) + e1 * bf_lo(bq.w) + e2 * bf_lo(cq.w), e0 * bf_hi(a.w) + e1 * bf_hi(bq.w) + e2 * bf_hi(cq.w));
                *(v4u*)(MIX + off) = o; }
        } break;
        case PH_FINAL: {
            const float* ssq = SUMSQ; const float* fg = PIN(19); float* OUT = (float*)OB;
            for (int i = gt; i < T * 128; i += NGT) { const int row = i >> 7, c8 = (i & 127) * 8; const f32x4* pp = (const f32x4*)(ssq + (size_t)row * 16); float tq = 0.f;
#pragma unroll
                for (int q = 0; q < 4; ++q) { const f32x4 pq = pp[q]; tq += (pq[0] + pq[1]) + (pq[2] + pq[3]); }
                const float rs = 1.0f / sqrtf(tq * (1.0f / 1024.0f) + EPS);
                const v4u xw = *(const v4u*)(X16 + blk_off(row, c8)); const f32x4 ga = *(const f32x4*)(fg + c8), gb = *(const f32x4*)(fg + c8 + 4);
                f32x4 oa = (f32x4){bf_lo(xw.x), bf_hi(xw.x), bf_lo(xw.y), bf_hi(xw.y)} * rs * ga, ob = (f32x4){bf_lo(xw.z), bf_hi(xw.z), bf_lo(xw.w), bf_hi(xw.w)} * rs * gb;
                float* op = OUT + (size_t)row * D + c8; *(f32x4*)op = oa; *(f32x4*)(op + 4) = ob; }
        } break;
        default: break;
        }
        if (ph + 1 < p.hi && !(type == PH_ROPE && sb == 1)) { if (ph == p.lo) grid.sync(); else { XcdBarrier xb_; xb_.bar = (unsigned*)(ws + WS_CTL); xb_.x = xb_xcc_id(); xb_.st = (volatile LAS unsigned*)(lds + 131072 + 2048); xcd_barrier(xb_); } }
    }
}

extern "C" void kernel_launch(void* const* d_in, const int* in_sizes, int n_in, void* d_out, int out_size, void* d_ws, size_t ws_size, hipStream_t stream) {
    static int grid = 0;
    if (grid == 0) {
        if (n_in != 20 || out_size != T * D || ws_size < WS_END) { fprintf(stderr, "kernel_launch: unexpected shapes (n_in %d, out %d, ws %zu, need %zu)\n", n_in, out_size, ws_size, (size_t)WS_END); grid = -1; return; }
        int dev = 0, cus = 0, per_cu = 0;
        hipGetDevice(&dev); hipDeviceGetAttribute(&cus, hipDeviceAttributeMultiprocessorCount, dev);
        if (hipFuncSetAttribute((const void*)fwd_megakernel, hipFuncAttributeMaxDynamicSharedMemorySize, LDS_BYTES) != hipSuccess) { fprintf(stderr, "kernel_launch: hipFuncSetAttribute failed\n"); grid = -1; return; }
        if (hipOccupancyMaxActiveBlocksPerMultiprocessor(&per_cu, (const void*)fwd_megakernel, 512, LDS_BYTES) != hipSuccess || per_cu < 1) { fprintf(stderr, "kernel_launch: occupancy query says %d\n", per_cu); per_cu = 1; }
        (void)hipGetLastError();
        grid = cus * 1;
        fprintf(stderr, "kernel_launch: grid %d (occupancy query %d per CU), ws %zu\n", grid, per_cu, ws_size);
    }
    if (grid < 0) return;
    Params p{};
    for (int i = 0; i < 20; ++i) p.in[i] = (const float*)d_in[i];
    p.out = (float*)d_out; p.ws = (unsigned char*)d_ws;
    for (int j = 0; j < 8; ++j) p.inv[j] = pow(500000.0, -(double)j / 8.0) / 6.283185307179586476925286766559;
#if MK_PER_PHASE
    for (int ph = 0; ph < NPH; ++ph) { p.lo = ph; p.hi = ph + 1; void* args[] = {&p};
        hipError_t e = hipLaunchCooperativeKernel((const void*)fwd_megakernel, dim3(grid), dim3(512), args, LDS_BYTES, stream);
        if (e != hipSuccess) { fprintf(stderr, "launch %d failed: %s\n", ph, hipGetErrorString(e)); break; } }
#else
    if (hipMemsetAsync((char*)d_ws + WS_CTL, 0, CTL_BYTES, stream) != hipSuccess) { fprintf(stderr, "kernel_launch: memset failed\n"); return; }
    p.lo = 0; p.hi = NPH; void* args[] = {&p};
    hipError_t e = hipLaunchCooperativeKernel((const void*)fwd_megakernel, dim3(grid), dim3(512), args, LDS_BYTES, stream);
    if (e != hipSuccess) fprintf(stderr, "cooperative launch failed: %s (grid %d)\n", hipGetErrorString(e), grid);
#endif
}
```
